# Optimizing an MI355X kernel written in HIP

```python
import jax, jax.numpy as jnp
from jax import lax
import numpy as np

D_MODEL = 4096
BATCH = 4
SEQ = 4096
DEPTH = 1

HEAD_DIM = 128
A_HEADS = 16
A_KV_HEADS = 4
A_GROUP = A_HEADS // A_KV_HEADS
B_PATTERNS = ((128, 1), (512, 4), (2048, 16))
B_HEADS_PER_GROUP = 8
B_N_GROUPS = len(B_PATTERNS)
B_HEADS = B_N_GROUPS * B_HEADS_PER_GROUP
A_Q_W = A_HEADS * HEAD_DIM
A_KV_W = A_KV_HEADS * HEAD_DIM
A_OUT_W = A_Q_W
B_QKV_W = 3 * B_HEADS * HEAD_DIM
B_OUT_W = B_HEADS_PER_GROUP * HEAD_DIM
GATE_W = 2 * D_MODEL
IN_W = A_Q_W + 2 * A_KV_W + B_QKV_W + GATE_W
D_FF = 11008
GRID_W = 64
ROPE_THETA = 10000.0
ROPE_AXIS_DIM = HEAD_DIM // 2
Q_BLOCK = 128
RMS_EPS = 1e-6
NEG_INF = -1e30

kernel_name = 'hybrid_gated_gqa_dilated_macaron'


def rms_norm(x, g):
    x32 = x.astype(jnp.float32)
    y = x32 * lax.rsqrt(jnp.mean(x32 * x32, axis=-1, keepdims=True) + RMS_EPS)
    return (y * g.astype(jnp.float32)).astype(x.dtype)


def swiglu(x, w_gate, w_up, w_down):
    return (jax.nn.silu(x @ w_gate) * (x @ w_up)) @ w_down


def axial_rope_angles(T):
    rows = T // GRID_W
    row_ids = jnp.repeat(jnp.arange(rows), GRID_W).astype(jnp.float32)
    col_ids = jnp.tile(jnp.arange(GRID_W), rows).astype(jnp.float32)
    inv = ROPE_THETA ** (-jnp.arange(0, ROPE_AXIS_DIM, 2, dtype=jnp.float32) / ROPE_AXIS_DIM)
    return row_ids[:, None] * inv[None, :], col_ids[:, None] * inv[None, :]


def _rotate_half(x, ang):
    half = x.shape[-1] // 2
    x1, x2 = x[..., :half], x[..., half:]
    c = jnp.cos(ang)[:, None, :]
    s = jnp.sin(ang)[:, None, :]
    return jnp.concatenate([x1 * c - x2 * s, x1 * s + x2 * c], axis=-1)


def apply_axial_rope(x, ang_r, ang_c):
    x32 = x.astype(jnp.float32)
    out = jnp.concatenate([_rotate_half(x32[..., :ROPE_AXIS_DIM], ang_r),
                           _rotate_half(x32[..., ROPE_AXIS_DIM:], ang_c)], axis=-1)
    return out.astype(x.dtype)


def global_gqa_attention(q, k, v):
    bsz, T = q.shape[0], q.shape[1]
    nb = T // Q_BLOCK
    qb = q.reshape(bsz, nb, Q_BLOCK, A_KV_HEADS, A_GROUP, HEAD_DIM).transpose(1, 0, 2, 3, 4, 5)
    scale = HEAD_DIM ** -0.5

    def block(qblk):
        s = jnp.einsum('bqkgd,bskd->bkgqs', qblk, k, preferred_element_type=jnp.float32) * scale
        p = jax.nn.softmax(s, axis=-1).astype(v.dtype)
        return jnp.einsum('bkgqs,bskd->bqkgd', p, v)

    out = lax.map(block, qb)
    return out.transpose(1, 0, 2, 3, 4, 5).reshape(bsz, T, A_OUT_W)


def dilated_window_attention(q, k, v, window, dilation, slopes):
    bsz, T, H, hd = q.shape
    half_span = window // 2
    n_side = half_span // dilation
    offsets = jnp.arange(-n_side, n_side + 1) * dilation
    k_pad = jnp.pad(k, ((0, 0), (half_span, half_span), (0, 0), (0, 0)))
    v_pad = jnp.pad(v, ((0, 0), (half_span, half_span), (0, 0), (0, 0)))
    bias = -slopes.astype(jnp.float32)[:, None] * jnp.abs(offsets).astype(jnp.float32)[None, :]
    nb = T // Q_BLOCK
    qb = q.reshape(bsz, nb, Q_BLOCK, H, hd).transpose(1, 0, 2, 3, 4)
    starts = jnp.arange(nb) * Q_BLOCK
    scale = hd ** -0.5

    def block(args):
        qblk, s0 = args
        pos = s0 + jnp.arange(Q_BLOCK)
        key_pos = pos[:, None] + offsets[None, :]
        valid = (key_pos >= 0) & (key_pos < T)
        idx = key_pos + half_span
        kb = jnp.take(k_pad, idx, axis=1)
        vb = jnp.take(v_pad, idx, axis=1)
        s = jnp.einsum('bqhd,bqjhd->bhqj', qblk, kb, preferred_element_type=jnp.float32) * scale
        s = jnp.where(valid[None, None], s + bias[:, None, :], NEG_INF)
        lse = jax.nn.logsumexp(s, axis=-1)
        p = jnp.exp(s - lse[..., None]).astype(v.dtype)
        o = jnp.einsum('bhqj,bqjhd->bqhd', p, vb)
        return o, lse.transpose(0, 2, 1)

    o, lse = lax.map(block, (qb, starts))
    o = o.transpose(1, 0, 2, 3, 4).reshape(bsz, T, H, hd)
    lse = lse.transpose(1, 0, 2, 3).reshape(bsz, T, H)
    return o, lse


def hybrid_layer(h, g_ffn1, w1_gate, w1_up, w1_down, g_mix, w_in, q_norm_a, k_norm_a,
                 w_branch_a, w_branch_b, w_out, g_ffn2, w2_gate, w2_up, w2_down):
    bsz, T, _ = h.shape
    h = h + 0.5 * swiglu(rms_norm(h, g_ffn1), w1_gate, w1_up, w1_down)

    u = rms_norm(h, g_mix)
    proj = u @ w_in
    c0 = A_Q_W
    c1 = c0 + A_KV_W
    c2 = c1 + A_KV_W
    c3 = c2 + B_QKV_W
    q_a = proj[..., :c0].reshape(bsz, T, A_HEADS, HEAD_DIM)
    k_a = proj[..., c0:c1].reshape(bsz, T, A_KV_HEADS, HEAD_DIM)
    v_a = proj[..., c1:c2].reshape(bsz, T, A_KV_HEADS, HEAD_DIM)
    qkv_b = proj[..., c2:c3].reshape(bsz, T, B_N_GROUPS, 3, B_HEADS_PER_GROUP, HEAD_DIM)
    gate_a = proj[..., c3:c3 + D_MODEL]
    gate_b = proj[..., c3 + D_MODEL:]

    ang_r, ang_c = axial_rope_angles(T)
    q_a = apply_axial_rope(rms_norm(q_a, q_norm_a), ang_r, ang_c)
    k_a = apply_axial_rope(rms_norm(k_a, k_norm_a), ang_r, ang_c)
    y_a = global_gqa_attention(q_a, k_a, v_a)

    slopes = jnp.exp2(-8.0 * jnp.arange(1, B_HEADS + 1, dtype=jnp.float32) / B_HEADS)
    outs, lses = [], []
    for gi, (window, dilation) in enumerate(B_PATTERNS):
        o, l = dilated_window_attention(qkv_b[:, :, gi, 0], qkv_b[:, :, gi, 1], qkv_b[:, :, gi, 2],
                                        window, dilation,
                                        slopes[gi * B_HEADS_PER_GROUP:(gi + 1) * B_HEADS_PER_GROUP])
        outs.append(o)
        lses.append(l)
    alpha = jax.nn.softmax(jnp.stack(lses, axis=0), axis=0)
    y_b = jnp.sum(alpha[..., None].astype(outs[0].dtype) * jnp.stack(outs, axis=0), axis=0)
    y_b = y_b.reshape(bsz, T, B_OUT_W)

    merged = jax.nn.sigmoid(gate_a) * (y_a @ w_branch_a) + jax.nn.sigmoid(gate_b) * (y_b @ w_branch_b)
    h = h + merged @ w_out

    h = h + 0.5 * swiglu(rms_norm(h, g_ffn2), w2_gate, w2_up, w2_down)
    return h


def setup_inputs(seed: int = 0) -> dict:
    key = jax.random.key(seed)
    ks = jax.random.split(key, 18)
    L = DEPTH

    def normal(k, shape, fan_in):
        return jax.random.normal(k, shape, jnp.float32) * (fan_in ** -0.5)

    def gain(k, shape):
        return 1.0 + 0.02 * jax.random.normal(k, shape, jnp.float32)

    return {
        'x': jax.random.normal(ks[0], (BATCH, SEQ, D_MODEL), jnp.float32),
        'g_ffn1': gain(ks[1], (L, D_MODEL)),
        'w1_gate': normal(ks[2], (L, D_MODEL, D_FF), D_MODEL),
        'w1_up': normal(ks[3], (L, D_MODEL, D_FF), D_MODEL),
        'w1_down': normal(ks[4], (L, D_FF, D_MODEL), D_FF),
        'g_mix': gain(ks[5], (L, D_MODEL)),
        'w_in': normal(ks[6], (L, D_MODEL, IN_W), D_MODEL),
        'q_norm_a': gain(ks[7], (L, HEAD_DIM)),
        'k_norm_a': gain(ks[8], (L, HEAD_DIM)),
        'w_branch_a': normal(ks[9], (L, A_OUT_W, D_MODEL), A_OUT_W),
        'w_branch_b': normal(ks[10], (L, B_OUT_W, D_MODEL), B_OUT_W),
        'w_out': normal(ks[11], (L, D_MODEL, D_MODEL), D_MODEL),
        'g_ffn2': gain(ks[12], (L, D_MODEL)),
        'w2_gate': normal(ks[13], (L, D_MODEL, D_FF), D_MODEL),
        'w2_up': normal(ks[14], (L, D_MODEL, D_FF), D_MODEL),
        'w2_down': normal(ks[15], (L, D_FF, D_MODEL), D_FF),
        'g_final': gain(ks[16], (D_MODEL,)),
    }


def reference(x, g_ffn1, w1_gate, w1_up, w1_down, g_mix, w_in, q_norm_a, k_norm_a,
              w_branch_a, w_branch_b, w_out, g_ffn2, w2_gate, w2_up, w2_down, g_final):
    h = x
    for l in range(DEPTH):
        h = hybrid_layer(h, g_ffn1[l], w1_gate[l], w1_up[l], w1_down[l], g_mix[l], w_in[l],
                         q_norm_a[l], k_norm_a[l], w_branch_a[l], w_branch_b[l], w_out[l],
                         g_ffn2[l], w2_gate[l], w2_up[l], w2_down[l])
    return rms_norm(h, g_final)
```

```cpp
#include <hip/hip_runtime.h>
#include <cstdio>
#include <cstdint>

__device__ __forceinline__ int lane_id() { int l; asm volatile("v_mbcnt_lo_u32_b32 %0, -1, 0\n\tv_mbcnt_hi_u32_b32 %0, -1, %0" : "=v"(l)); return l; }
namespace pg8 {
#define PG8_LAS __attribute__((address_space(3)))
typedef unsigned short bf16_t;
typedef short bf16x8 __attribute__((ext_vector_type(8)));
typedef float f32x4 __attribute__((ext_vector_type(4)));
typedef unsigned u32x4 __attribute__((ext_vector_type(4)));
typedef int i32x4 __attribute__((ext_vector_type(4)));
template <bool I8> struct AccT { typedef f32x4 type; };
template <> struct AccT<true> { typedef i32x4 type; };
constexpr int BM = 256, BK = 64, HALF = 128, HTB = HALF * BK * 2  , STAGE_BYTES = 8 * HTB, NXCD = 8, WGM = 8;

__host__ __device__ __forceinline__ int lds_byte(int r, int c) { const int rr = r & 7, g = c >> 3; return (r >> 3) * 1024 + (rr * 8 + (g ^ (2 * (rr >> 1)))) * 16 + (c & 7) * 2; }
__host__ __device__ __forceinline__ void stage_rc(int b, int& R, int& C) { const int p = (b % 1024) / 16, rr = p >> 3, g = (p & 7) ^ (2 * (rr >> 1)); R = (b / 1024) * 8 + rr; C = g * 8 + (b % 16) / 2; }
__host__ __device__ __forceinline__ int perm32(int rho) { const int n = rho >> 4, i = rho & 15; return 8 * (i >> 2) + 4 * n + (i & 3); }

struct Unit { int pm, pn; };
struct Gemm { const bf16_t* A; const bf16_t* Bt; int M, N, K, lda, ldb; size_t kpA, kpB; };

struct StaticOrder {
    int nM, nN, nwg, G, c;
    __host__ __device__ void init(int M, int N, int G_, int c_) { nM = M / BM; nN = N / BM; nwg = nM * nN; G = G_; c = c_; }
    __host__ __device__ bool next(int i, Unit& u) const {
        const long L = (long)i * G + c; if (L >= nwg) return false;
        int wgid = (int)L; { const int q = nwg / NXCD, r = nwg % NXCD, xcd = wgid % NXCD, off = wgid / NXCD; wgid = (xcd < r ? xcd * (q + 1) : r * (q + 1) + (xcd - r) * q) + off; }
        const int nig = WGM * nN, gid = wgid / nig, fm = gid * WGM, gsz = (nM - fm) < WGM ? (nM - fm) : WGM;
        u.pm = fm + ((wgid % nig) % gsz); u.pn = (wgid % nig) / gsz; return true;
    }
    __device__ __forceinline__ void a_ready(const Unit&) const {}
    __device__ __forceinline__ void done(const Unit&) const {}
};

struct BandOrder {
    StaticOrder so; int G, c;
    __host__ __device__ void init(int M, int N, int G_, int c_) { so.init(M, N, G_, c_); G = G_; c = c_; }
    __host__ __device__ bool next(int i, Unit& u) const {
        if (G != 256 || so.nM != 64 || so.nN != 16) return so.next(i, u);
        if (i >= 4) return false;
        const int x = c & 7, j = c >> 3;
        u.pm = 16 * i + 4 * (x & 3) + (j & 3); u.pn = 8 * (x >> 2) + (j >> 2); return true;
    }
    __device__ __forceinline__ void a_ready(const Unit&) const {}
    __device__ __forceinline__ void done(const Unit&) const {}
};

__device__ __forceinline__ unsigned cvt_pk_bf16(float lo, float hi) { unsigned r; asm volatile("v_cvt_pk_bf16_f32 %0, %1, %2" : "=v"(r) : "v"(lo), "v"(hi)); return r; }
__device__ __forceinline__ float bf_lo(unsigned w) { return __uint_as_float(w << 16); }
__device__ __forceinline__ float bf_hi(unsigned w) { return __uint_as_float(w & 0xffff0000u); }
__device__ __forceinline__ float sigmoid_f(float x) { return __builtin_amdgcn_rcpf(1.0f + __builtin_amdgcn_exp2f(-1.4426950408889634f * x)); }

__device__ __forceinline__ int ss_index(int pm, int wr, int fr, int ai, int m) { return pm * 256 + wr * 128 + fr * 8 + ai * 4 + m; }
__device__ __forceinline__ void load_rstd8(const float* ss, int pm, int wr, int fr, float inv_n, float eps, float (&sc)[2][4]) {
    const f32x4 a = *(const f32x4*)(ss + ss_index(pm, wr, fr, 0, 0)), b = *(const f32x4*)(ss + ss_index(pm, wr, fr, 1, 0));
#pragma unroll
    for (int m = 0; m < 4; ++m) { sc[0][m] = __builtin_amdgcn_rsqf(a[m] * inv_n + eps); sc[1][m] = __builtin_amdgcn_rsqf(b[m] * inv_n + eps); }
}
__host__ __device__ __forceinline__ int dil_row(int row, int dsh) { const int t = row & 4095; return (row & ~4095) | ((t & ((1 << dsh) - 1)) << (12 - dsh)) | (t >> dsh); }
struct EpiBf16 {
    static constexpr bool PERM = true, AFTER_DRAIN = false;
    bf16_t* HM; int nrows; unsigned char* G; int ldg; const float* ss; float inv_n, eps; int pn_d4, pn_d16, pn_gate;
    __device__ __forceinline__ void operator()(const f32x4 (&acc)[2][2][4][2], const Unit& u, int wr, int wc, int fr, int fq) const {
        const int row0 = u.pm * BM + wr * 64 + fr, cw = wc * 32 + 8 * fq;
        const bool is_gate = u.pn >= pn_gate;
        const int dsh = (u.pn >= pn_d4 && !is_gate) ? (u.pn >= pn_d16 ? 4 : 2) : 0;
        float scv[2][4];
        load_rstd8(ss, u.pm, wr, fr, inv_n, eps, scv);
#pragma unroll
        for (int ai = 0; ai < 2; ++ai)
#pragma unroll
            for (int m = 0; m < 4; ++m) { const int row = row0 + ai * HALF + m * 16; const float sc = scv[ai][m];
#pragma unroll
                for (int bj = 0; bj < 2; ++bj) { const f32x4 v0 = acc[ai][bj][m][0] * sc, v1 = acc[ai][bj][m][1] * sc;
                    if (is_gate) {
                        unsigned q[8];
#pragma unroll
                        for (int e = 0; e < 4; ++e) { q[e] = (unsigned)(sigmoid_f(v0[e]) * 255.0f + 0.5f); q[4 + e] = (unsigned)(sigmoid_f(v1[e]) * 255.0f + 0.5f); }
                        const unsigned long long pk = (unsigned long long)(q[0] | (q[1] << 8) | (q[2] << 16) | (q[3] << 24)) | ((unsigned long long)(q[4] | (q[5] << 8) | (q[6] << 16) | (q[7] << 24)) << 32);
                        *(unsigned long long*)(G + (size_t)row * ldg + (u.pn - pn_gate) * BM + bj * HALF + cw) = pk;
                    } else {
                        u32x4 w; w.x = cvt_pk_bf16(v0[0], v0[1]); w.y = cvt_pk_bf16(v0[2], v0[3]); w.z = cvt_pk_bf16(v1[0], v1[1]); w.w = cvt_pk_bf16(v1[2], v1[3]);
                        *(u32x4*)(HM + ((size_t)(2 * u.pn + bj) * nrows + dil_row(row, dsh)) * HALF + cw) = w; } } }
    }
};
struct EpiBf16Q {
    static constexpr bool PERM = true, AFTER_DRAIN = false;
    bf16_t* HM; int nrows; unsigned char* G; int ldg; const float* rs; const float* cs; int pn_d4, pn_d16, pn_gate;
    __device__ __forceinline__ void operator()(const i32x4 (&acc)[2][2][4][2], const Unit& u, int wr, int wc, int fr, int fq) const {
        const int row0 = u.pm * BM + wr * 64 + fr, cw = wc * 32 + 8 * fq;
        const bool is_gate = u.pn >= pn_gate;
        const int dsh = (u.pn >= pn_d4 && !is_gate) ? (u.pn >= pn_d16 ? 4 : 2) : 0;
        float scv[2][4];
        { const f32x4 a = *(const f32x4*)(rs + ss_index(u.pm, wr, fr, 0, 0)), b = *(const f32x4*)(rs + ss_index(u.pm, wr, fr, 1, 0));
#pragma unroll
          for (int m = 0; m < 4; ++m) { scv[0][m] = a[m]; scv[1][m] = b[m]; } }
        f32x4 cc[2][2];
#pragma unroll
        for (int bj = 0; bj < 2; ++bj) { const float* cp = cs + u.pn * BM + bj * HALF + cw; cc[bj][0] = *(const f32x4*)cp; cc[bj][1] = *(const f32x4*)(cp + 4); }
#pragma unroll
        for (int ai = 0; ai < 2; ++ai)
#pragma unroll
            for (int m = 0; m < 4; ++m) { const int row = row0 + ai * HALF + m * 16; const float sc = scv[ai][m];
#pragma unroll
                for (int bj = 0; bj < 2; ++bj) { const i32x4 i0 = acc[ai][bj][m][0], i1 = acc[ai][bj][m][1];
                    const f32x4 v0 = (f32x4){(float)i0[0], (float)i0[1], (float)i0[2], (float)i0[3]} * cc[bj][0] * sc, v1 = (f32x4){(float)i1[0], (float)i1[1], (float)i1[2], (float)i1[3]} * cc[bj][1] * sc;
                    if (is_gate) {
                        unsigned q[8];
#pragma unroll
                        for (int e = 0; e < 4; ++e) { q[e] = (unsigned)(sigmoid_f(v0[e]) * 255.0f + 0.5f); q[4 + e] = (unsigned)(sigmoid_f(v1[e]) * 255.0f + 0.5f); }
                        const unsigned long long pk = (unsigned long long)(q[0] | (q[1] << 8) | (q[2] << 16) | (q[3] << 24)) | ((unsigned long long)(q[4] | (q[5] << 8) | (q[6] << 16) | (q[7] << 24)) << 32);
                        *(unsigned long long*)(G + (size_t)row * ldg + (u.pn - pn_gate) * BM + bj * HALF + cw) = pk;
                    } else {
                        u32x4 w; w.x = cvt_pk_bf16(v0[0], v0[1]); w.y = cvt_pk_bf16(v0[2], v0[3]); w.z = cvt_pk_bf16(v1[0], v1[1]); w.w = cvt_pk_bf16(v1[2], v1[3]);
                        *(u32x4*)(HM + ((size_t)(2 * u.pn + bj) * nrows + dil_row(row, dsh)) * HALF + cw) = w; } } }
    }
};
struct EpiSwiGLU {
    static constexpr bool PERM = true, AFTER_DRAIN = false;
    bf16_t* O; int nrows; const float* ss; float inv_n, eps;
    __device__ __forceinline__ void operator()(const f32x4 (&acc)[2][2][4][2], const Unit& u, int wr, int wc, int fr, int fq) const {
        const int row0 = u.pm * BM + wr * 64 + fr, col0 = wc * 32 + 8 * fq;
        bf16_t* Ob = O + (size_t)u.pn * nrows * HALF;
        float scv[2][4];
        if (ss) load_rstd8(ss, u.pm, wr, fr, inv_n, eps, scv);
#pragma unroll
        for (int ai = 0; ai < 2; ++ai)
#pragma unroll
            for (int m = 0; m < 4; ++m) { const int row = row0 + ai * HALF + m * 16; bf16_t* rowp = Ob + (size_t)row * HALF + col0;
                const float sc = ss ? scv[ai][m] : 1.0f;
                float h[8];
#pragma unroll
                for (int n = 0; n < 2; ++n)
#pragma unroll
                    for (int e = 0; e < 4; ++e) { const float g = acc[ai][0][m][n][e] * sc, up = acc[ai][1][m][n][e] * sc; h[4 * n + e] = g * sigmoid_f(g) * up; }
                u32x4 w; w.x = cvt_pk_bf16(h[0], h[1]); w.y = cvt_pk_bf16(h[2], h[3]); w.z = cvt_pk_bf16(h[4], h[5]); w.w = cvt_pk_bf16(h[6], h[7]);
                *(u32x4*)rowp = w; }
    }
};
struct EpiSwiGLUQ {
    static constexpr bool PERM = true, AFTER_DRAIN = false;
    EpiSwiGLU base; const float* rs; const float* cs;
    __device__ __forceinline__ void mid(f32x4 (&acc)[2][2][4][2], const Unit& u, int wr, int wc, int fr, int fq) const {
        const int col0 = u.pn * BM + wc * 32 + 8 * fq;
        f32x4 cc[2][2];
#pragma unroll
        for (int bj = 0; bj < 2; ++bj) { const float* cp = cs + col0 + bj * HALF; cc[bj][0] = *(const f32x4*)cp; cc[bj][1] = *(const f32x4*)(cp + 4); }
#pragma unroll
        for (int ai = 0; ai < 2; ++ai) { const f32x4 rsv = *(const f32x4*)(rs + ss_index(u.pm, wr, fr, ai, 0));
#pragma unroll
            for (int m = 0; m < 4; ++m)
#pragma unroll
                for (int bj = 0; bj < 2; ++bj)
#pragma unroll
                    for (int n = 0; n < 2; ++n)
#pragma unroll
                        for (int e = 0; e < 4; ++e) acc[ai][bj][m][n][e] = (float)__float_as_int(acc[ai][bj][m][n][e]) * (rsv[m] * cc[bj][n][e]); }
    }
    __device__ __forceinline__ void operator()(const f32x4 (&acc)[2][2][4][2], const Unit& u, int wr, int wc, int fr, int fq) const { base(acc, u, wr, wc, fr, fq); }
};
template <bool RES_BF16, bool OUT_BF16, bool STATS> struct EpiRes {
    static constexpr bool PERM = true, AFTER_DRAIN = false;
    const void* res; int ldr; void* out; int ldo; float alpha; float* ss;
    __device__ __forceinline__ void operator()(const f32x4 (&acc)[2][2][4][2], const Unit& u, int wr, int wc, int fr, int fq) const {
        const int row0 = u.pm * BM + wr * 64 + fr, col0 = u.pn * BM + wc * 32 + 8 * fq;
#pragma unroll
        for (int ai = 0; ai < 2; ++ai) {
            f32x4 rf[4][2][2]; u32x4 rb[4][2];
#pragma unroll
            for (int m = 0; m < 4; ++m) { const size_t ro = (size_t)(row0 + ai * HALF + m * 16) * ldr + col0;
#pragma unroll
                for (int bj = 0; bj < 2; ++bj) {
                    if constexpr (RES_BF16) rb[m][bj] = *(const u32x4*)((const bf16_t*)res + ro + bj * HALF);
                    else { rf[m][bj][0] = *(const f32x4*)((const float*)res + ro + bj * HALF); rf[m][bj][1] = *(const f32x4*)((const float*)res + ro + bj * HALF + 4); } } }
            __builtin_amdgcn_sched_barrier(0);
#pragma unroll
            for (int m = 0; m < 4; ++m) { const int row = row0 + ai * HALF + m * 16; const size_t oo = (size_t)row * ldo + col0;
                float sq = 0.f;
#pragma unroll
                for (int bj = 0; bj < 2; ++bj) { f32x4 r0, r1;
                    if constexpr (RES_BF16) { const u32x4 w = rb[m][bj]; r0 = (f32x4){bf_lo(w.x), bf_hi(w.x), bf_lo(w.y), bf_hi(w.y)}; r1 = (f32x4){bf_lo(w.z), bf_hi(w.z), bf_lo(w.w), bf_hi(w.w)}; }
                    else { r0 = rf[m][bj][0]; r1 = rf[m][bj][1]; }
                    const f32x4 h0 = r0 + acc[ai][bj][m][0] * alpha, h1 = r1 + acc[ai][bj][m][1] * alpha;
                    if constexpr (STATS) sq += ((h0[0] * h0[0] + h0[1] * h0[1]) + (h0[2] * h0[2] + h0[3] * h0[3])) + ((h1[0] * h1[0] + h1[1] * h1[1]) + (h1[2] * h1[2] + h1[3] * h1[3]));
                    if constexpr (OUT_BF16) { u32x4 w; w.x = cvt_pk_bf16(h0[0], h0[1]); w.y = cvt_pk_bf16(h0[2], h0[3]); w.z = cvt_pk_bf16(h1[0], h1[1]); w.w = cvt_pk_bf16(h1[2], h1[3]);
                        *(u32x4*)((bf16_t*)out + oo + bj * HALF) = w; }
                    else { *(f32x4*)((float*)out + oo + bj * HALF) = h0; *(f32x4*)((float*)out + oo + bj * HALF + 4) = h1; } }
                if constexpr (STATS) { sq += __shfl_xor(sq, 16); sq += __shfl_xor(sq, 32);
                    if (fq == 0) __hip_atomic_fetch_add(ss + ss_index(u.pm, wr, fr, ai, m), sq, __ATOMIC_RELAXED, __HIP_MEMORY_SCOPE_AGENT); } }
            __builtin_amdgcn_sched_barrier(0);
        }
    }
};
struct EpiResQ {
    static constexpr bool PERM = true, AFTER_DRAIN = false;
    const bf16_t* res; int ldr; bf16_t* out; int ldo; const float* rs; const float* cs; float* ss;
    __device__ __forceinline__ void operator()(const i32x4 (&acc)[2][2][4][2], const Unit& u, int wr, int wc, int fr, int fq) const {
        const int row0 = u.pm * BM + wr * 64 + fr, col0 = u.pn * BM + wc * 32 + 8 * fq;
        f32x4 cc[2][2];
#pragma unroll
        for (int bj = 0; bj < 2; ++bj) { const float* cp = cs + col0 + bj * HALF; cc[bj][0] = *(const f32x4*)cp; cc[bj][1] = *(const f32x4*)(cp + 4); }
#pragma unroll
        for (int ai = 0; ai < 2; ++ai) {
            u32x4 rb[4][2];
            const f32x4 rsv = *(const f32x4*)(rs + ss_index(u.pm, wr, fr, ai, 0));
#pragma unroll
            for (int m = 0; m < 4; ++m) { const size_t ro = (size_t)(row0 + ai * HALF + m * 16) * ldr + col0;
#pragma unroll
                for (int bj = 0; bj < 2; ++bj) rb[m][bj] = *(const u32x4*)(res + ro + bj * HALF); }
            __builtin_amdgcn_sched_barrier(0);
#pragma unroll
            for (int m = 0; m < 4; ++m) { const int row = row0 + ai * HALF + m * 16; const size_t oo = (size_t)row * ldo + col0; const float sc = rsv[m];
                float sq = 0.f;
#pragma unroll
                for (int bj = 0; bj < 2; ++bj) { const u32x4 w = rb[m][bj];
                    const f32x4 r0 = (f32x4){bf_lo(w.x), bf_hi(w.x), bf_lo(w.y), bf_hi(w.y)}, r1 = (f32x4){bf_lo(w.z), bf_hi(w.z), bf_lo(w.w), bf_hi(w.w)};
                    const i32x4 i0 = acc[ai][bj][m][0], i1 = acc[ai][bj][m][1];
                    const f32x4 h0 = r0 + (f32x4){(float)i0[0], (float)i0[1], (float)i0[2], (float)i0[3]} * cc[bj][0] * sc, h1 = r1 + (f32x4){(float)i1[0], (float)i1[1], (float)i1[2], (float)i1[3]} * cc[bj][1] * sc;
                    sq += ((h0[0] * h0[0] + h0[1] * h0[1]) + (h0[2] * h0[2] + h0[3] * h0[3])) + ((h1[0] * h1[0] + h1[1] * h1[1]) + (h1[2] * h1[2] + h1[3] * h1[3]));
                    u32x4 o; o.x = cvt_pk_bf16(h0[0], h0[1]); o.y = cvt_pk_bf16(h0[2], h0[3]); o.z = cvt_pk_bf16(h1[0], h1[1]); o.w = cvt_pk_bf16(h1[2], h1[3]);
                    *(u32x4*)(out + oo + bj * HALF) = o; }
                sq += __shfl_xor(sq, 16); sq += __shfl_xor(sq, 32);
                if (fq == 0) __hip_atomic_fetch_add(ss + ss_index(u.pm, wr, fr, ai, m), sq, __ATOMIC_RELAXED, __HIP_MEMORY_SCOPE_AGENT); }
            __builtin_amdgcn_sched_barrier(0);
        }
    }
};
struct EpiGateAB {
    static constexpr bool PERM = true, AFTER_DRAIN = false; static constexpr int MIDT = 32;
    const unsigned char* sigA; const unsigned char* sigB; int ldg; bf16_t* O; int ldc;
    __device__ __forceinline__ void mid(f32x4 (&acc)[2][2][4][2], const Unit& u, int wr, int wc, int fr, int fq) const {
        const int row0 = u.pm * BM + wr * 64 + fr, col0 = u.pn * BM + wc * 32 + 8 * fq;
#pragma unroll
        for (int ai = 0; ai < 2; ++ai) {
            unsigned long long ga[4][2], gb[4][2];
#pragma unroll
            for (int m = 0; m < 4; ++m) { const size_t ro = (size_t)(row0 + ai * HALF + m * 16) * ldg + col0;
#pragma unroll
                for (int bj = 0; bj < 2; ++bj) { ga[m][bj] = *(const unsigned long long*)(sigA + ro + bj * HALF); gb[m][bj] = *(const unsigned long long*)(sigB + ro + bj * HALF); } }
            __builtin_amdgcn_sched_barrier(0);
#pragma unroll
            for (int m = 0; m < 4; ++m)
#pragma unroll
                for (int bj = 0; bj < 2; ++bj) { const unsigned alo = (unsigned)ga[m][bj], ahi = (unsigned)(ga[m][bj] >> 32), blo = (unsigned)gb[m][bj], bhi = (unsigned)(gb[m][bj] >> 32);
#pragma unroll
                    for (int e = 0; e < 4; ++e) { const unsigned b0 = (blo >> (8 * e)) & 0xffu, b1 = (bhi >> (8 * e)) & 0xffu;
                        acc[ai][bj][m][0][e] *= (float)((alo >> (8 * e)) & 0xffu) * __builtin_amdgcn_rcpf((float)(b0 ? b0 : 1u));
                        acc[ai][bj][m][1][e] *= (float)((ahi >> (8 * e)) & 0xffu) * __builtin_amdgcn_rcpf((float)(b1 ? b1 : 1u)); } }
            __builtin_amdgcn_sched_barrier(0);
        }
    }
    __device__ __forceinline__ void operator()(const f32x4 (&acc)[2][2][4][2], const Unit& u, int wr, int wc, int fr, int fq) const {
        const int row0 = u.pm * BM + wr * 64 + fr, col0 = u.pn * BM + wc * 32 + 8 * fq;
        unsigned long long gb[2][4][2];
#pragma unroll
        for (int ai = 0; ai < 2; ++ai)
#pragma unroll
            for (int m = 0; m < 4; ++m) { const size_t ro = (size_t)(row0 + ai * HALF + m * 16) * ldg + col0;
#pragma unroll
                for (int bj = 0; bj < 2; ++bj) gb[ai][m][bj] = *(const unsigned long long*)(sigB + ro + bj * HALF); }
        __builtin_amdgcn_sched_barrier(0);
#pragma unroll
        for (int ai = 0; ai < 2; ++ai)
#pragma unroll
            for (int m = 0; m < 4; ++m) { const size_t row = (size_t)(row0 + ai * HALF + m * 16);
#pragma unroll
                for (int bj = 0; bj < 2; ++bj) { const unsigned blo = (unsigned)gb[ai][m][bj], bhi = (unsigned)(gb[ai][m][bj] >> 32);
                    float r[8];
#pragma unroll
                    for (int e = 0; e < 4; ++e) { const unsigned b0 = (blo >> (8 * e)) & 0xffu, b1 = (bhi >> (8 * e)) & 0xffu;
                        r[e] = acc[ai][bj][m][0][e] * ((float)(b0 ? b0 : 1u) * (1.0f / 255.0f)); r[4 + e] = acc[ai][bj][m][1][e] * ((float)(b1 ? b1 : 1u) * (1.0f / 255.0f)); }
                    u32x4 w; w.x = cvt_pk_bf16(r[0], r[1]); w.y = cvt_pk_bf16(r[2], r[3]); w.z = cvt_pk_bf16(r[4], r[5]); w.w = cvt_pk_bf16(r[6], r[7]);
                    *(u32x4*)(O + row * ldc + col0 + bj * HALF) = w; } }
    }
};
struct EpiGateABQ {
    static constexpr bool PERM = true, AFTER_DRAIN = false; static constexpr int MIDT = 16;
    EpiGateAB base; const float* rs; const float* cs;
    __device__ __forceinline__ void mid(f32x4 (&acc)[2][2][4][2], const Unit& u, int wr, int wc, int fr, int fq) const {
        const int row0 = u.pm * BM + wr * 64 + fr, col0 = u.pn * BM + wc * 32 + 8 * fq;
        f32x4 cc[2][2];
#pragma unroll
        for (int bj = 0; bj < 2; ++bj) { const float* cp = cs + col0 + bj * HALF; cc[bj][0] = *(const f32x4*)cp; cc[bj][1] = *(const f32x4*)(cp + 4); }
#pragma unroll
        for (int ai = 0; ai < 2; ++ai) {
            unsigned long long ga[4][2], gb[4][2];
            const f32x4 rsv = *(const f32x4*)(rs + ss_index(u.pm, wr, fr, ai, 0));
#pragma unroll
            for (int m = 0; m < 4; ++m) { const size_t ro = (size_t)(row0 + ai * HALF + m * 16) * base.ldg + col0;
#pragma unroll
                for (int bj = 0; bj < 2; ++bj) { ga[m][bj] = *(const unsigned long long*)(base.sigA + ro + bj * HALF); gb[m][bj] = *(const unsigned long long*)(base.sigB + ro + bj * HALF); } }
            __builtin_amdgcn_sched_barrier(0);
#pragma unroll
            for (int m = 0; m < 4; ++m)
#pragma unroll
                for (int bj = 0; bj < 2; ++bj) { const unsigned alo = (unsigned)ga[m][bj], ahi = (unsigned)(ga[m][bj] >> 32), blo = (unsigned)gb[m][bj], bhi = (unsigned)(gb[m][bj] >> 32);
#pragma unroll
                    for (int e = 0; e < 4; ++e) { const unsigned b0 = (blo >> (8 * e)) & 0xffu, b1 = (bhi >> (8 * e)) & 0xffu;
                        acc[ai][bj][m][0][e] = (float)__float_as_int(acc[ai][bj][m][0][e]) * (rsv[m] * cc[bj][0][e]) * ((float)((alo >> (8 * e)) & 0xffu) * __builtin_amdgcn_rcpf((float)(b0 ? b0 : 1u)));
                        acc[ai][bj][m][1][e] = (float)__float_as_int(acc[ai][bj][m][1][e]) * (rsv[m] * cc[bj][1][e]) * ((float)((ahi >> (8 * e)) & 0xffu) * __builtin_amdgcn_rcpf((float)(b1 ? b1 : 1u))); } }
            __builtin_amdgcn_sched_barrier(0);
        }
    }
    __device__ __forceinline__ void operator()(const f32x4 (&acc)[2][2][4][2], const Unit& u, int wr, int wc, int fr, int fq) const { base(acc, u, wr, wc, fr, fq); }
};
template <class E> struct has_mid { static constexpr int value = 0; };
template <> struct has_mid<EpiGateAB> { static constexpr int value = EpiGateAB::MIDT; };

template <bool I8> __device__ __forceinline__ typename AccT<I8>::type pg8_mma(bf16x8 b, bf16x8 a, typename AccT<I8>::type c) {
    if constexpr (I8) return __builtin_amdgcn_mfma_i32_16x16x64_i8(__builtin_bit_cast(i32x4, b), __builtin_bit_cast(i32x4, a), c, 0, 0, 0);
    else return __builtin_amdgcn_mfma_f32_16x16x32_bf16(b, a, c, 0, 0, 0);
}
template <class Epi, class Sched, bool ALIGN_EPI = false, bool I8 = false  ,
          int MIXT = 0  >
__device__ __forceinline__ void gemm_phase(PG8_LAS unsigned char* lds, const Gemm g, const Sched& S, const Epi& E, const int wid  ) {
    const int lane = lane_id(), tid = wid * 64 + lane, wr = wid >> 2, wc = wid & 3, fr = lane & 15, fq = lane >> 4;
    const int K = g.K, nt = K / BK;
    const __amdgpu_buffer_rsrc_t rA = __builtin_amdgcn_make_buffer_rsrc((void*)g.A, 0, 0x7fffffff, 0x00020000), rB = __builtin_amdgcn_make_buffer_rsrc((void*)g.Bt, 0, 0x7fffffff, 0x00020000);
    unsigned voffA[2], voffB[2];
#pragma unroll
    for (int i = 0; i < 2; ++i) { int R, C; stage_rc(tid * 16 + i * 8192, R, C); const int Rb = Epi::PERM ? ((R & ~31) + perm32(R & 31)) : R;
        voffA[i] = (unsigned)(R * g.lda + C) * 2u; voffB[i] = (unsigned)(Rb * g.ldb + C) * 2u; }
    const unsigned kstep = (unsigned)(BK * 2);
    const unsigned hstepA = (unsigned)HALF * g.lda * 2u, hstepB = (unsigned)HALF * g.ldb * 2u;
    const unsigned tstepA = 2 * hstepA, tstepB = 2 * hstepB;
    const unsigned kpA = (unsigned)g.kpA, kpB = (unsigned)g.kpB;
    const unsigned ldsw = (unsigned)wid * 1024u;
    const int aoff[2] = {lds_byte(wr * 64 + fr, fq * 8), lds_byte(wr * 64 + fr, 32 + fq * 8)}, boff[2] = {lds_byte(wc * 32 + fr, fq * 8), lds_byte(wc * 32 + fr, 32 + fq * 8)};
#define PG8_SA(b, h) (((b) * 2 + (h)) * HTB)
#define PG8_SB(b, h) ((4 + (b) * 2 + (h)) * HTB)
#define PG8_STAGE(bufoff, rsrc, soff, voff) do { _Pragma("unroll") for (int _i = 0; _i < 2; ++_i) \
        __builtin_amdgcn_raw_ptr_buffer_load_lds(rsrc, (PG8_LAS void*)(lds + (bufoff) + ldsw + _i * 8192), 16, (voff)[_i], (soff), 0, 0); } while (0)
#define PG8_LDA(dst, b, h) do { _Pragma("unroll") for (int m = 0; m < 4; ++m) _Pragma("unroll") for (int k = 0; k < 2; ++k) dst[m][k] = *(const PG8_LAS bf16x8*)(lds + PG8_SA(b, h) + aoff[k] + m * 2048); } while (0)
#define PG8_LDB(dst, b, h) do { _Pragma("unroll") for (int n = 0; n < 2; ++n) _Pragma("unroll") for (int k = 0; k < 2; ++k) dst[n][k] = *(const PG8_LAS bf16x8*)(lds + PG8_SB(b, h) + boff[k] + n * 2048); } while (0)
#define PG8_MMA(ai, bj, At, Bt) do { __builtin_amdgcn_s_setprio(1); _Pragma("unroll") for (int m = 0; m < 4; ++m) _Pragma("unroll") for (int n = 0; n < 2; ++n) _Pragma("unroll") for (int k = 0; k < 2; ++k) \
        acc[ai][bj][m][n] = pg8_mma<I8>(Bt[n][k], At[m][k], acc[ai][bj][m][n]); __builtin_amdgcn_s_setprio(0); } while (0)
#define PG8_MMA_Q(ai, bj, At, Bt) do { __builtin_amdgcn_s_setprio(1); _Pragma("unroll") for (int m = 0; m < 4; ++m) _Pragma("unroll") for (int n = 0; n < 2; ++n) _Pragma("unroll") for (int k = 0; k < 2; ++k) \
        acc[ai][bj][m][n] = __builtin_bit_cast(acc_t, __builtin_amdgcn_mfma_i32_16x16x64_i8(__builtin_bit_cast(i32x4, Bt[n][k]), __builtin_bit_cast(i32x4, At[m][k]), __builtin_bit_cast(i32x4, acc[ai][bj][m][n]), 0, 0, 0)); __builtin_amdgcn_s_setprio(0); } while (0)
#define PG8_WAIT_V(n) asm volatile("s_waitcnt vmcnt(" #n ")" ::: "memory")
#define PG8_WAIT_L(n) asm volatile("s_waitcnt lgkmcnt(" #n ")" ::: "memory")
#define PG8_BAR __builtin_amdgcn_s_barrier()
#define PG8_SCHED __builtin_amdgcn_sched_barrier(0)
    Unit cur, nxt; int ui = 0;
    if (!S.next(0, cur)) return;
    typedef typename AccT<I8>::type acc_t;
    acc_t acc[2][2][4][2];
#pragma unroll
    for (int a = 0; a < 2; ++a)
#pragma unroll
        for (int b = 0; b < 2; ++b)
#pragma unroll
            for (int m = 0; m < 4; ++m)
#pragma unroll
                for (int n = 0; n < 2; ++n) acc[a][b][m][n] = (acc_t)(0);
    bf16x8 At[4][2], B0[2][2], B1[2][2];
    unsigned cA = (unsigned)cur.pm * tstepA, cB = (unsigned)cur.pn * tstepB;
    S.a_ready(cur);
    PG8_STAGE(PG8_SB(0, 0), rB, cB, voffB); PG8_STAGE(PG8_SB(0, 1), rB, cB + hstepB, voffB); PG8_STAGE(PG8_SA(0, 0), rA, cA, voffA); PG8_STAGE(PG8_SA(0, 1), rA, cA + hstepA, voffA);
    if (wr == 1) PG8_BAR;
    PG8_WAIT_V(2); PG8_BAR;
    PG8_STAGE(PG8_SB(1, 0), rB, cB + kstep, voffB); PG8_STAGE(PG8_SA(1, 0), rA, cA + kstep, voffA); PG8_STAGE(PG8_SB(1, 1), rB, cB + hstepB + kstep, voffB);
    PG8_WAIT_V(6); PG8_BAR;
    for (;;) {
        const bool has_next = S.next(ui + 1, nxt);
        const unsigned nA = has_next ? (unsigned)nxt.pm * tstepA : cA, nB = has_next ? (unsigned)nxt.pn * tstepB : cB;
#define PG8_KSTEP(MM) do { \
            const bool last = (t == nt - 2); \
            const unsigned a1 = cA + (unsigned)(t >> 1) * kpA + kstep; \
            const unsigned a2 = last ? nA : cA + (unsigned)((t >> 1) + 1) * kpA, b2 = last ? nB : cB + (unsigned)((t >> 1) + 1) * kpB; \
            const unsigned a3 = a2 + kstep, b3 = b2 + kstep; \
            if (last && has_next) S.a_ready(nxt); \
            PG8_LDB(B0, 0, 0); PG8_LDB(B1, 0, 1); PG8_SCHED; PG8_LDA(At, 0, 0); PG8_STAGE(PG8_SA(1, 1), rA, a1 + hstepA, voffA); \
            PG8_WAIT_V(8); PG8_WAIT_L(0); PG8_BAR; MM(0, 0, At, B0); MM(0, 1, At, B1); PG8_BAR; PG8_SCHED; \
            PG8_LDA(At, 0, 1); PG8_STAGE(PG8_SB(0, 0), rB, b2, voffB); PG8_STAGE(PG8_SB(0, 1), rB, b2 + hstepB, voffB); PG8_STAGE(PG8_SA(0, 0), rA, a2, voffA); \
            PG8_WAIT_V(8); PG8_WAIT_L(0); PG8_BAR; MM(1, 0, At, B0); MM(1, 1, At, B1); PG8_BAR; PG8_SCHED; \
            PG8_LDB(B0, 1, 0); PG8_LDB(B1, 1, 1); PG8_SCHED; PG8_LDA(At, 1, 0); PG8_STAGE(PG8_SA(0, 1), rA, a2 + hstepA, voffA); \
            PG8_WAIT_V(8); PG8_WAIT_L(0); PG8_BAR; MM(0, 0, At, B0); MM(0, 1, At, B1); PG8_BAR; PG8_SCHED; \
            PG8_LDA(At, 1, 1); PG8_STAGE(PG8_SB(1, 0), rB, b3, voffB); PG8_STAGE(PG8_SB(1, 1), rB, b3 + hstepB, voffB); PG8_STAGE(PG8_SA(1, 0), rA, a3, voffA); \
            PG8_WAIT_V(8); PG8_WAIT_L(0); PG8_BAR; MM(1, 0, At, B0); MM(1, 1, At, B1); PG8_BAR; PG8_SCHED; } while (0)
        if constexpr (MIXT > 0) {
            for (int t = 0; t < MIXT; t += 2) PG8_KSTEP(PG8_MMA_Q);
            E.mid(acc, cur, wr, wc, fr, fq);
            for (int t = MIXT; t < nt; t += 2) PG8_KSTEP(PG8_MMA);
        } else {
            for (int t = 0; t < nt; t += 2) {
                if constexpr (has_mid<Epi>::value > 0) { if (t == has_mid<Epi>::value) E.mid(acc, cur, wr, wc, fr, fq); }
                PG8_KSTEP(PG8_MMA);
            }
        }
#undef PG8_KSTEP
        if constexpr (ALIGN_EPI) { if (wr == 0) PG8_BAR; }
        E(acc, cur, wr, wc, fr, fq); S.done(cur);
        if (!has_next) break;
#pragma unroll
        for (int a = 0; a < 2; ++a)
#pragma unroll
            for (int b = 0; b < 2; ++b)
#pragma unroll
                for (int m = 0; m < 4; ++m)
#pragma unroll
                    for (int n = 0; n < 2; ++n) acc[a][b][m][n] = (acc_t)(0);
        cur = nxt; cA = nA; cB = nB; ++ui;
        if constexpr (ALIGN_EPI) { if (wr == 1) PG8_BAR; }
    }
    PG8_WAIT_V(0);
    if constexpr (!ALIGN_EPI) { if (wr == 0) PG8_BAR; }
    PG8_BAR;
#undef PG8_SA
#undef PG8_SB
#undef PG8_STAGE
#undef PG8_LDA
#undef PG8_LDB
#undef PG8_MMA
#undef PG8_MMA_Q
#undef PG8_WAIT_V
#undef PG8_WAIT_L
#undef PG8_BAR
#undef PG8_SCHED
}
}

#define GAS __attribute__((address_space(1)))
#define LAS __attribute__((address_space(3)))
typedef unsigned short bf16;
typedef unsigned v4u __attribute__((ext_vector_type(4)));
typedef float f32x4 __attribute__((ext_vector_type(4)));
typedef GAS unsigned gu32;
#define RLX_AGENT __ATOMIC_RELAXED, __HIP_MEMORY_SCOPE_AGENT
#define LDS_WAIT() asm volatile("s_waitcnt lgkmcnt(0)" ::: "memory")
#define VM_WAIT() asm volatile("s_waitcnt vmcnt(0)" ::: "memory")

namespace att {
using bf16x8 = __attribute__((ext_vector_type(8))) short;
using s16x4  = __attribute__((ext_vector_type(4))) short;
using f32x16 = __attribute__((ext_vector_type(16))) float;
using u32x4  = __attribute__((ext_vector_type(4))) unsigned;
constexpr int   D = 128, NW = 8, QBLK = 32, KVBLK = 64;
constexpr float SCALE = 0.088388347648318440f;
constexpr float THR = 8.f;
constexpr int SHM_V = KVBLK * D * 2, SHM_K = KVBLK * D * 2, SHM_ATTN = 2 * SHM_V + 2 * SHM_K + NW * 64 * 4;
#define KSWZ(row, colB) ((row) * 256 + ((colB) ^ (((row) & 15) << 4)))
#define SBAR() __builtin_amdgcn_sched_barrier(0)
__device__ __forceinline__ int crow(int r, int hi) { return (r & 3) + 8 * (r >> 2) + 4 * hi; }
__device__ __forceinline__ unsigned cvtpk(float lo, float hi) { unsigned r; asm volatile("v_cvt_pk_bf16_f32 %0, %1, %2" : "=v"(r) : "v"(lo), "v"(hi)); return r; }

__device__ __forceinline__ void partialSM(f32x16& p0, f32x16& p1, float& m_reg, float& mn, float& alpha) {
  constexpr float C = SCALE * 1.4426950408889634f;
  float pmax = p0[0];
#pragma unroll
  for (int r = 1; r < 16; ++r) pmax = fmaxf(pmax, p0[r]);
#pragma unroll
  for (int r = 0; r < 16; ++r) pmax = fmaxf(pmax, p1[r]);
  { auto rr = __builtin_amdgcn_permlane32_swap(__float_as_uint(pmax), __float_as_uint(pmax), false, false);
    pmax = fmaxf(__uint_as_float(rr[0]), __uint_as_float(rr[1])); }
  if (__builtin_expect(__all(pmax - m_reg <= THR / SCALE), 1)) { mn = m_reg; alpha = 1.f; }
  else { mn = fmaxf(m_reg, pmax); alpha = __builtin_amdgcn_exp2f((m_reg - mn) * C); m_reg = mn; }
  float mnC = -mn * C;
#pragma unroll
  for (int r = 0; r < 16; ++r) p0[r] = fmaf(p0[r], C, mnC);
#pragma unroll
  for (int r = 0; r < 16; ++r) p1[r] = fmaf(p1[r], C, mnC);
#pragma unroll
  for (int r = 0; r < 16; ++r) p0[r] = __builtin_amdgcn_exp2f(p0[r]);
}
__device__ __forceinline__ void finishSM(f32x16& p0, f32x16& p1, float alpha, float& l_reg, bf16x8& pa0, bf16x8& pa1, bf16x8& pa2, bf16x8& pa3) {
#pragma unroll
  for (int r = 0; r < 16; ++r) p1[r] = __builtin_amdgcn_exp2f(p1[r]);
  float ps = 0;
#pragma unroll
  for (int r = 0; r < 16; ++r) ps += p0[r];
#pragma unroll
  for (int r = 0; r < 16; ++r) ps += p1[r];
  { auto rr = __builtin_amdgcn_permlane32_swap(__float_as_uint(ps), __float_as_uint(ps), false, false);
    ps = __uint_as_float(rr[0]) + __uint_as_float(rr[1]); }
  l_reg = l_reg * alpha + ps;
#define PK4(P, BASE, OUT) do { unsigned a0 = cvtpk(P[BASE + 0], P[BASE + 1]), a1 = cvtpk(P[BASE + 2], P[BASE + 3]);   \
    unsigned b0 = cvtpk(P[BASE + 4], P[BASE + 5]), b1 = cvtpk(P[BASE + 6], P[BASE + 7]);                              \
    auto r0 = __builtin_amdgcn_permlane32_swap(a0, b0, false, false); auto r1 = __builtin_amdgcn_permlane32_swap(a1, b1, false, false); \
    u32x4 w = {r0[0], r1[0], r0[1], r1[1]}; OUT = *reinterpret_cast<bf16x8*>(&w); } while (0)
  PK4(p0, 0, pa0); PK4(p0, 8, pa1); PK4(p1, 0, pa2); PK4(p1, 8, pa3);
#undef PK4
}
__device__ __forceinline__ void qkt(f32x16& p0, f32x16& p1, const LAS char* Ks, const bf16x8* qr, int r32, int hi) {
  p0 = f32x16{}; p1 = f32x16{};
#pragma unroll
  for (int d0 = 0; d0 < 8; ++d0) { int cb = (d0 * 16 + hi * 8) * 2;
    bf16x8 b0 = *reinterpret_cast<const LAS bf16x8*>(Ks + KSWZ(r32, cb));
    bf16x8 b1 = *reinterpret_cast<const LAS bf16x8*>(Ks + KSWZ(32 + r32, cb));
    p0 = __builtin_amdgcn_mfma_f32_32x32x16_bf16(b0, qr[d0], p0, 0, 0, 0);
    p1 = __builtin_amdgcn_mfma_f32_32x32x16_bf16(b1, qr[d0], p1, 0, 0, 0); }
}
__device__ __forceinline__ int v_st(int k, int c) { const int kk = (k & ~0xC) | ((k & 4) << 1) | ((k & 8) >> 1); return ((kk >> 3) * 4 + (c >> 5)) * 512 + ((kk & 7) * 32 + (c & 31)) * 2; }
__device__ __forceinline__ int v_rd_base(int lane) { return ((lane & 3) << 3) | (((lane >> 2) & 3) << 6) | (((lane >> 4) & 1) << 5) | (((lane >> 5) & 1) << 8); }
constexpr int v_rd_off(int d0, int ks, int half) { return d0 * 512 + ks * 4096 + half * 2048; }
template <int OFF> __device__ __forceinline__ s16x4 tr_read(int vb) {
  s16x4 r; asm volatile("ds_read_b64_tr_b16 %0, %1 offset:%2" : "=&v"(r) : "v"(vb), "i"(OFF) : "memory"); return r;
}
template <int D0> __device__ __forceinline__ void pv_one(f32x16& od, int vb, bf16x8 pa0, bf16x8 pa1, bf16x8 pa2, bf16x8 pa3) {
  const s16x4 l0 = tr_read<v_rd_off(D0, 0, 0)>(vb), h0 = tr_read<v_rd_off(D0, 0, 1)>(vb), l1 = tr_read<v_rd_off(D0, 1, 0)>(vb), h1 = tr_read<v_rd_off(D0, 1, 1)>(vb);
  const s16x4 l2 = tr_read<v_rd_off(D0, 2, 0)>(vb), h2 = tr_read<v_rd_off(D0, 2, 1)>(vb), l3 = tr_read<v_rd_off(D0, 3, 0)>(vb), h3 = tr_read<v_rd_off(D0, 3, 1)>(vb);
  asm volatile("s_waitcnt lgkmcnt(0)" ::: "memory"); SBAR();
#define PK(L, H) (bf16x8){L[0], L[1], L[2], L[3], H[0], H[1], H[2], H[3]}
  od = __builtin_amdgcn_mfma_f32_32x32x16_bf16(pa0, PK(l0, h0), od, 0, 0, 0);
  od = __builtin_amdgcn_mfma_f32_32x32x16_bf16(pa1, PK(l1, h1), od, 0, 0, 0);
  od = __builtin_amdgcn_mfma_f32_32x32x16_bf16(pa2, PK(l2, h2), od, 0, 0, 0);
  od = __builtin_amdgcn_mfma_f32_32x32x16_bf16(pa3, PK(l3, h3), od, 0, 0, 0);
#undef PK
}
__device__ __forceinline__ void pv_d0(f32x16* o, int vb, bf16x8 pa0, bf16x8 pa1, bf16x8 pa2, bf16x8 pa3) {
  pv_one<0>(o[0], vb, pa0, pa1, pa2, pa3); pv_one<1>(o[1], vb, pa0, pa1, pa2, pa3); pv_one<2>(o[2], vb, pa0, pa1, pa2, pa3); pv_one<3>(o[3], vb, pa0, pa1, pa2, pa3);
}

template <bool WIN>
__device__ __forceinline__ void attn_unit(const bf16* __restrict__ Qb, int ldq, const bf16* __restrict__ Kh, const bf16* __restrict__ Vh, int ldk,
                                          bf16* __restrict__ Ob, int ldo, float* __restrict__ lse, int ldl,
                                          int NT, int kb0, int i0, int L, float slope_raw, LAS char* lds, const int wid  ) {
  int lane = lane_id(); asm volatile("" : "+v"(lane));
  const int tid = wid * 64 + lane, r32 = lane & 31, hi = lane >> 5;
  LAS char* V_lds = lds; LAS char* K_lds = lds + 2 * SHM_V;
  LAS float* ws = (LAS float*)(lds + 2 * SHM_V + 2 * SHM_K) + wid * 64; LAS float* li_l = ws; LAS float* al_l = ws + 32;
  float m_reg = -1e30f, l_reg = 0; f32x16 o[4] = {}; bf16x8 qr[8];
  { const unsigned qoff = (unsigned)((wid * QBLK + r32) * ldq + hi * 8) * 2u;
#pragma unroll
    for (int d0 = 0; d0 < 8; ++d0) qr[d0] = *reinterpret_cast<const bf16x8*>((const char*)Qb + qoff + d0 * 32); }
  const int sr = tid >> 4, sc = (tid & 15) * 8, vst0 = v_st(sr, sc), vst1 = v_st(32 + sr, sc);
  const int vb0 = (int)(uintptr_t)V_lds + v_rd_base(lane);
  const int qi = i0 + wid * QBLK + r32;
  const unsigned soff0 = (unsigned)(sr * ldk + sc) * 2u, soff1 = soff0 + (unsigned)(32 * ldk) * 2u;
  struct { bf16x8 vs0, vs1, ks0, ks1; } sr_[2];
#define KROW(t) (WIN ? min(max(kb0 + (t) * KVBLK, 0), L - KVBLK) : (t) * KVBLK)
#define SLOAD(i, k0) do { const size_t _ko = (size_t)(k0) * (size_t)ldk * 2; const char* _vb = (const char*)Vh + _ko; const char* _kb = (const char*)Kh + _ko; \
    sr_[i].vs0 = *reinterpret_cast<const bf16x8*>(_vb + soff0); sr_[i].vs1 = *reinterpret_cast<const bf16x8*>(_vb + soff1); \
    sr_[i].ks0 = *reinterpret_cast<const bf16x8*>(_kb + soff0); sr_[i].ks1 = *reinterpret_cast<const bf16x8*>(_kb + soff1); } while (0)
#define SWRITE(b, i) do { *(LAS bf16x8*)(V_lds + (b) * SHM_V + vst0) = sr_[i].vs0;          \
    *(LAS bf16x8*)(V_lds + (b) * SHM_V + vst1) = sr_[i].vs1; int kc = sc * 2;               \
    *(LAS bf16x8*)(K_lds + (b) * SHM_K + KSWZ(sr, kc)) = sr_[i].ks0;                       \
    *(LAS bf16x8*)(K_lds + (b) * SHM_K + KSWZ(32 + sr, kc)) = sr_[i].ks1; } while (0)
#define SWAIT() asm volatile("s_waitcnt vmcnt(4)" ::: "memory")
#define RESC(a) do { if (__any((a) < 1.f)) { if (hi == 0) al_l[r32] = (a); asm volatile("s_waitcnt lgkmcnt(0)" ::: "memory"); \
    _Pragma("unroll") for (int d = 0; d < 4; ++d) _Pragma("unroll") for (int r = 0; r < 16; ++r) o[d][r] *= al_l[crow(r, hi)]; } } while (0)
#define MASK(P0, P1, t) do { if constexpr (WIN) { const int kb = kb0 + (t) * KVBLK; const bool tok = (kb >= 0) && (kb < L); const float dlf = tok ? (float)(kb + 4 * hi - qi) : 1.0e9f; \
    _Pragma("unroll") for (int r = 0; r < 16; ++r) { const float d0 = dlf + (float)((r & 3) + 8 * (r >> 2)), d1 = d0 + 32.f; \
      P0[r] = (__builtin_fabsf(d0) <= 64.f) ? fmaf(-slope_raw, __builtin_fabsf(d0), P0[r]) : -__builtin_inff(); \
      P1[r] = (__builtin_fabsf(d1) <= 64.f) ? fmaf(-slope_raw, __builtin_fabsf(d1), P1[r]) : -__builtin_inff(); } } } while (0)
  f32x16 pA0, pA1, pB0, pB1; float mnA, mnB, alA, alB; bf16x8 pa0, pa1, pa2, pa3;
  constexpr int SE = 0, SO = 1;
  SLOAD(SE, KROW(0)); asm volatile("s_waitcnt vmcnt(0)" ::: "memory"); SWRITE(0, SE); __syncthreads();
  qkt(pA0, pA1, K_lds, qr, r32, hi); MASK(pA0, pA1, 0); partialSM(pA0, pA1, m_reg, mnA, alA);
  SLOAD(SO, KROW(1)); if (2 < NT) SLOAD(SE, KROW(2));
  SWAIT(); SWRITE(1, SO); __syncthreads();
  for (int j = 1; j + 1 < NT; j += 2) {
    SBAR(); qkt(pB0, pB1, K_lds + SHM_K, qr, r32, hi);
    finishSM(pA0, pA1, alA, l_reg, pa0, pa1, pa2, pa3); SBAR();
    SLOAD(SO, KROW(j + 2)); SBAR();
    pv_d0(o, vb0, pa0, pa1, pa2, pa3); MASK(pB0, pB1, j); partialSM(pB0, pB1, m_reg, mnB, alB);
    __syncthreads(); SWAIT(); SWRITE(0, SE);
    RESC(alB); __syncthreads();
    SBAR(); qkt(pA0, pA1, K_lds, qr, r32, hi);
    finishSM(pB0, pB1, alB, l_reg, pa0, pa1, pa2, pa3); SBAR();
    if (j + 3 < NT) SLOAD(SE, KROW(j + 3)); SBAR();
    pv_d0(o, vb0 + SHM_V, pa0, pa1, pa2, pa3); MASK(pA0, pA1, j + 1); partialSM(pA0, pA1, m_reg, mnA, alA);
    __syncthreads(); SWAIT(); SWRITE(1, SO);
    RESC(alA); __syncthreads();
  }
  SBAR(); qkt(pB0, pB1, K_lds + SHM_K, qr, r32, hi);
  finishSM(pA0, pA1, alA, l_reg, pa0, pa1, pa2, pa3); SBAR();
  pv_d0(o, vb0, pa0, pa1, pa2, pa3); MASK(pB0, pB1, NT - 1); partialSM(pB0, pB1, m_reg, mnB, alB);
  __syncthreads(); RESC(alB);
  finishSM(pB0, pB1, alB, l_reg, pa0, pa1, pa2, pa3); SBAR();
  pv_d0(o, vb0 + SHM_V, pa0, pa1, pa2, pa3);
  if (hi == 0) li_l[r32] = l_reg; asm volatile("s_waitcnt lgkmcnt(0)" ::: "memory");
  float rli[16];
#pragma unroll
  for (int r = 0; r < 16; ++r) rli[r] = __builtin_amdgcn_rcpf(li_l[crow(r, hi)]);
#pragma unroll
  for (int r = 0; r < 16; ++r) { const unsigned ooff = (unsigned)((wid * QBLK + crow(r, hi)) * ldo + r32) * 2u;
#pragma unroll
    for (int d0 = 0; d0 < 4; ++d0) *(bf16*)((char*)Ob + ooff + d0 * 64) = (bf16)(cvtpk(o[d0][r] * rli[r], 0.f) & 0xffffu); }
  if constexpr (WIN) { if (hi == 0) lse[(size_t)((wid * QBLK + r32) * ldl)] = SCALE * m_reg + __logf(l_reg); }
#undef KROW
#undef SLOAD
#undef SWRITE
#undef SWAIT
#undef RESC
#undef MASK
}
__device__ __forceinline__ void dense_unit(const bf16* __restrict__ Qb, const bf16* __restrict__ Kh, const bf16* __restrict__ Vh, bf16* __restrict__ Ob, int ldo, int NT, LAS char* lds, const int wid) {
  int lane = lane_id(); asm volatile("" : "+v"(lane));
  const int r32 = lane & 31, hi = lane >> 5;
  LAS char* V_lds = lds; LAS char* K_lds = lds + 2 * SHM_V;
  LAS float* ws = (LAS float*)(lds + 2 * SHM_V + 2 * SHM_K) + wid * 64; LAS float* li_l = ws; LAS float* al_l = ws + 32;
  const __amdgpu_buffer_rsrc_t rK = __builtin_amdgcn_make_buffer_rsrc((void*)Kh, 0, 0x7fffffff, 0x00020000), rV = __builtin_amdgcn_make_buffer_rsrc((void*)Vh, 0, 0x7fffffff, 0x00020000);
  unsigned koff[2], voff[2];
#pragma unroll
  for (int i = 0; i < 2; ++i) { const int pc = wid * 2 + i, row = 4 * pc + (lane >> 4); koff[i] = (unsigned)(row * 256 + (((lane & 15) ^ (row & 15)) << 4));
    const int o = pc * 1024 + lane * 16, sub = o >> 9, w_ = (o & 511) >> 1, kk = (sub >> 2) * 8 + (w_ >> 5), c = (sub & 3) * 32 + (w_ & 31), k = (kk & ~0xC) | ((kk & 4) << 1) | ((kk & 8) >> 1);
    voff[i] = (unsigned)(k * 256 + c * 2); }
#define KDMA(t, b) do { const unsigned so_ = (unsigned)(t) * (unsigned)(KVBLK * 256); _Pragma("unroll") for (int i_ = 0; i_ < 2; ++i_) \
    __builtin_amdgcn_raw_ptr_buffer_load_lds(rK, (LAS void*)(K_lds + (b) * SHM_K + wid * 2048 + i_ * 1024), 16, koff[i_], so_, 0, 0); } while (0)
#define VDMA(t, b) do { const unsigned so_ = (unsigned)(t) * (unsigned)(KVBLK * 256); _Pragma("unroll") for (int i_ = 0; i_ < 2; ++i_) \
    __builtin_amdgcn_raw_ptr_buffer_load_lds(rV, (LAS void*)(V_lds + (b) * SHM_V + wid * 2048 + i_ * 1024), 16, voff[i_], so_, 0, 0); } while (0)
#define SYNCPT() do { asm volatile("s_waitcnt vmcnt(0) lgkmcnt(0)" ::: "memory"); __builtin_amdgcn_s_barrier(); asm volatile("" ::: "memory"); } while (0)
#define RESC(a) do { if (__any((a) < 1.f)) { if (hi == 0) al_l[r32] = (a); asm volatile("s_waitcnt lgkmcnt(0)" ::: "memory"); \
    _Pragma("unroll") for (int d = 0; d < 4; ++d) _Pragma("unroll") for (int r = 0; r < 16; ++r) o[d][r] *= al_l[crow(r, hi)]; } } while (0)
  SYNCPT();
  KDMA(0, 0); VDMA(0, 0); KDMA(1, 1);
  float m_reg = -1e30f, l_reg = 0; f32x16 o[4] = {}; bf16x8 qr[8];
  { const unsigned qoff = (unsigned)((wid * QBLK + r32) * D + hi * 8) * 2u;
#pragma unroll
    for (int d0 = 0; d0 < 8; ++d0) qr[d0] = *reinterpret_cast<const bf16x8*>((const char*)Qb + qoff + d0 * 32); }
  const int vb0 = (int)(uintptr_t)V_lds + v_rd_base(lane);
  f32x16 pA0, pA1, pB0, pB1; float mnA, mnB, alA, alB; bf16x8 pa0, pa1, pa2, pa3;
  SYNCPT();
  qkt(pA0, pA1, K_lds, qr, r32, hi); partialSM(pA0, pA1, m_reg, mnA, alA);
  SYNCPT(); KDMA(2, 0); VDMA(1, 1);
  for (int j = 1; j + 1 < NT; j += 2) {
    SBAR(); qkt(pB0, pB1, K_lds + SHM_K, qr, r32, hi);
    finishSM(pA0, pA1, alA, l_reg, pa0, pa1, pa2, pa3); SBAR();
    pv_d0(o, vb0, pa0, pa1, pa2, pa3); partialSM(pB0, pB1, m_reg, mnB, alB);
    SYNCPT(); KDMA(j + 2, 1); VDMA(j + 1, 0);
    RESC(alB);
    SBAR(); qkt(pA0, pA1, K_lds, qr, r32, hi);
    finishSM(pB0, pB1, alB, l_reg, pa0, pa1, pa2, pa3); SBAR();
    pv_d0(o, vb0 + SHM_V, pa0, pa1, pa2, pa3); partialSM(pA0, pA1, m_reg, mnA, alA);
    SYNCPT(); if (j + 3 < NT) KDMA(j + 3, 0); VDMA(j + 2, 1);
    RESC(alA);
  }
  SBAR(); qkt(pB0, pB1, K_lds + SHM_K, qr, r32, hi);
  finishSM(pA0, pA1, alA, l_reg, pa0, pa1, pa2, pa3); SBAR();
  pv_d0(o, vb0, pa0, pa1, pa2, pa3); partialSM(pB0, pB1, m_reg, mnB, alB);
  SYNCPT(); RESC(alB);
  finishSM(pB0, pB1, alB, l_reg, pa0, pa1, pa2, pa3); SBAR();
  pv_d0(o, vb0 + SHM_V, pa0, pa1, pa2, pa3);
  if (hi == 0) li_l[r32] = l_reg; asm volatile("s_waitcnt lgkmcnt(0)" ::: "memory");
  float rli[16];
#pragma unroll
  for (int r = 0; r < 16; ++r) rli[r] = __builtin_amdgcn_rcpf(li_l[crow(r, hi)]);
#pragma unroll
  for (int r = 0; r < 16; ++r) { const unsigned ooff = (unsigned)((wid * QBLK + crow(r, hi)) * ldo + r32) * 2u;
#pragma unroll
    for (int d0 = 0; d0 < 4; ++d0) *(bf16*)((char*)Ob + ooff + d0 * 64) = (bf16)(cvtpk(o[d0][r] * rli[r], 0.f) & 0xffffu); }
#undef KDMA
#undef VDMA
#undef SYNCPT
#undef RESC
}
__device__ __forceinline__ void win_unit(const bf16* __restrict__ Qp, const bf16* __restrict__ Kp, const bf16* __restrict__ Vp, bf16* __restrict__ Op, int ldo, float* __restrict__ lsep, int ldl,
                                         int i0, int L, float slope_raw, LAS char* lds, const int wid) {
  int lane = lane_id(); asm volatile("" : "+v"(lane));
  const int r32 = lane & 31, hi = lane >> 5, kstart = i0 - 64;
  constexpr float C = SCALE * 1.4426950408889634f;
  LAS float* li_l = (LAS float*)(lds + 98304 + wid * 256);
  const __amdgpu_buffer_rsrc_t rK = __builtin_amdgcn_make_buffer_rsrc((void*)Kp, 0, 0x7fffffff, 0x00020000), rV = __builtin_amdgcn_make_buffer_rsrc((void*)Vp, 0, 0x7fffffff, 0x00020000);
  __syncthreads();
#pragma unroll
  for (int j = 0; j < 12; ++j) { const int pc = wid * 12 + j, row = 4 * pc + (lane >> 4), chunk = (lane & 15) ^ (row & 15);
    const int grow = min(max(kstart + row, 0), L - 1);
    __builtin_amdgcn_raw_ptr_buffer_load_lds(rK, (LAS void*)(lds + pc * 1024), 16, (unsigned)(grow * 256 + chunk * 16), 0, 0, 0); }
  bf16x8 qr[8];
  { const bf16* q = Qp + (size_t)(wid * 32 + r32) * D + hi * 8;
#pragma unroll
    for (int d0 = 0; d0 < 8; ++d0) qr[d0] = *reinterpret_cast<const bf16x8*>(q + d0 * 16); }
  asm volatile("s_waitcnt vmcnt(0)" ::: "memory"); __syncthreads();
  f32x16 p[5];
#pragma unroll
  for (int s = 0; s < 5; ++s) {
    const int rb = 32 * wid + 32 * s;
    const bool tok = (kstart + rb >= 0) && (kstart + rb < L);
    f32x16 acc = {};
#pragma unroll
    for (int d0 = 0; d0 < 8; ++d0) { const int cb = (d0 * 16 + hi * 8) * 2;
      const bf16x8 kf = *reinterpret_cast<const LAS bf16x8*>(lds + rb * 256 + KSWZ(r32, cb));
      acc = __builtin_amdgcn_mfma_f32_32x32x16_bf16(kf, qr[d0], acc, 0, 0, 0); }
    const float dlf = tok ? (float)(32 * s - 64 + 4 * hi - r32) : 1.0e9f;
#pragma unroll
    for (int r = 0; r < 16; ++r) { const float dd = dlf + (float)((r & 3) + 8 * (r >> 2));
      acc[r] = (__builtin_fabsf(dd) <= 64.f) ? fmaf(-slope_raw, __builtin_fabsf(dd), acc[r]) : -__builtin_inff(); }
    p[s] = acc;
  }
  asm volatile("s_waitcnt lgkmcnt(0)" ::: "memory"); __syncthreads();
#pragma unroll
  for (int j = 0; j < 12; ++j) { const int pc = wid * 12 + j, img = pc >> 4, o = (pc & 15) * 1024 + lane * 16;
    const int sub = o >> 9, w_ = (o & 511) >> 1, kk = (sub >> 2) * 8 + (w_ >> 5), c = (sub & 3) * 32 + (w_ & 31), k = (kk & ~0xC) | ((kk & 4) << 1) | ((kk & 8) >> 1);
    const int grow = min(max(kstart + img * 64 + k, 0), L - 1);
    __builtin_amdgcn_raw_ptr_buffer_load_lds(rV, (LAS void*)(lds + pc * 1024), 16, (unsigned)(grow * 256 + c * 2), 0, 0, 0); }
  float m = p[0][0];
#pragma unroll
  for (int s = 0; s < 5; ++s)
#pragma unroll
    for (int r = 0; r < 16; ++r) m = fmaxf(m, p[s][r]);
  { auto rr = __builtin_amdgcn_permlane32_swap(__float_as_uint(m), __float_as_uint(m), false, false); m = fmaxf(__uint_as_float(rr[0]), __uint_as_float(rr[1])); }
  const float mC = -m * C; float l = 0.f;
#pragma unroll
  for (int s = 0; s < 5; ++s)
#pragma unroll
    for (int r = 0; r < 16; ++r) { const float e = __builtin_amdgcn_exp2f(fmaf(p[s][r], C, mC)); p[s][r] = e; l += e; }
  { auto rr = __builtin_amdgcn_permlane32_swap(__float_as_uint(l), __float_as_uint(l), false, false); l = __uint_as_float(rr[0]) + __uint_as_float(rr[1]); }
  bf16x8 pa[5][2];
#define WPK4(P, BASE, OUT) do { unsigned a0 = cvtpk(P[BASE + 0], P[BASE + 1]), a1 = cvtpk(P[BASE + 2], P[BASE + 3]);   \
    unsigned b0 = cvtpk(P[BASE + 4], P[BASE + 5]), b1 = cvtpk(P[BASE + 6], P[BASE + 7]);                              \
    auto r0 = __builtin_amdgcn_permlane32_swap(a0, b0, false, false); auto r1 = __builtin_amdgcn_permlane32_swap(a1, b1, false, false); \
    u32x4 w = {r0[0], r1[0], r0[1], r1[1]}; OUT = *reinterpret_cast<bf16x8*>(&w); } while (0)
#pragma unroll
  for (int s = 0; s < 5; ++s) { WPK4(p[s], 0, pa[s][0]); WPK4(p[s], 8, pa[s][1]); }
#undef WPK4
  asm volatile("s_waitcnt vmcnt(0)" ::: "memory"); __syncthreads();
  f32x16 o[4] = {};
  const int vb0 = (int)(uintptr_t)lds + v_rd_base(lane);
#pragma unroll
  for (int s = 0; s < 5; ++s) {
    const int ko = 32 * wid + 32 * s;
    const int vb = vb0 + (ko >> 6) * 16384 + ((ko >> 5) & 1) * 8192;
#define WPV(D0) do { const s16x4 l0 = tr_read<v_rd_off(D0, 0, 0)>(vb), h0 = tr_read<v_rd_off(D0, 0, 1)>(vb), l1 = tr_read<v_rd_off(D0, 1, 0)>(vb), h1 = tr_read<v_rd_off(D0, 1, 1)>(vb); \
      asm volatile("s_waitcnt lgkmcnt(0)" ::: "memory"); SBAR(); \
      o[D0] = __builtin_amdgcn_mfma_f32_32x32x16_bf16(pa[s][0], (bf16x8){l0[0], l0[1], l0[2], l0[3], h0[0], h0[1], h0[2], h0[3]}, o[D0], 0, 0, 0); \
      o[D0] = __builtin_amdgcn_mfma_f32_32x32x16_bf16(pa[s][1], (bf16x8){l1[0], l1[1], l1[2], l1[3], h1[0], h1[1], h1[2], h1[3]}, o[D0], 0, 0, 0); } while (0)
    WPV(0); WPV(1); WPV(2); WPV(3);
#undef WPV
  }
  if (hi == 0) li_l[r32] = l; asm volatile("s_waitcnt lgkmcnt(0)" ::: "memory");
  float rli[16];
#pragma unroll
  for (int r = 0; r < 16; ++r) rli[r] = __builtin_amdgcn_rcpf(li_l[crow(r, hi)]);
#pragma unroll
  for (int r = 0; r < 16; ++r) { const unsigned ooff = (unsigned)((wid * 32 + crow(r, hi)) * ldo + r32) * 2u;
#pragma unroll
    for (int d0 = 0; d0 < 4; ++d0) *(bf16*)((char*)Op + ooff + d0 * 64) = (bf16)(cvtpk(o[d0][r] * rli[r], 0.f) & 0xffffu); }
  if (hi == 0) lsep[(size_t)((wid * 32 + r32) * ldl)] = SCALE * m + __logf(l);
}
}

constexpr int NWAVES = 8;
constexpr int BATCH = 4, T = 4096, DM = 4096, M = BATCH * T, FF = 11008, HD = 128;
constexpr int INW = 20480, C_QA = 0, C_KA = 2048, C_VA = 2560, C_QKVB = 3072, C_GA = 12288, C_GB = 16384;
constexpr int GW = 8192;
constexpr int S_QA = 0, S_KA = 16, S_VA = 20, S_B = 24, N_SLOTS = 96;
constexpr int YW = 3072;
constexpr float RMS_EPS = 1e-6f;
constexpr int N_PHASES = 12;
constexpr int KQ1 = 2048, ROWB1 = KQ1 + (DM - KQ1) * 2;

constexpr size_t MiB = 1u << 20;
constexpr size_t WS_CTL = 0, CTL_ZERO_BYTES = 1 * MiB;
constexpr size_t WS_WGU = 2 * MiB;
constexpr size_t WS_WDN = 174 * MiB;
constexpr size_t WS_WIN = 260 * MiB;
constexpr size_t WS_WBR = 420 * MiB;
constexpr size_t WS_WOUT = 444 * MiB;
constexpr size_t WS_XN = 476 * MiB;
constexpr size_t WS_BIG = 604 * MiB;
constexpr size_t WS_Y = 1244 * MiB;
constexpr size_t WS_OG = 1340 * MiB;
constexpr size_t WS_LSE = 1436 * MiB;
constexpr size_t WS_XN2 = 1438 * MiB;
constexpr size_t WS_END = 1566 * MiB;
constexpr int CW_BAR = 4096;
constexpr int CW_SS1 = 65536, CW_SS2 = 65536 + 16384;
static_assert((CW_SS2 + 16384) * 4 <= (int)CTL_ZERO_BYTES, "ctl map");

constexpr int RING_OFF = 0, RING_BYTES = 131072;
constexpr int LDSCTL_OFF = RING_BYTES, MISC_OFF = LDSCTL_OFF + 320;
constexpr int LDS_BYTES = 147456;
static_assert(att::SHM_ATTN <= RING_BYTES, "attention LDS inside the ring region");

#define XB_TMO      128
#define XB_XCNT(j)  (256  + 64 * (j))
#define XB_XSUB(j)  (1280 + 64 * (j))
#define XB_XGEN(j)  (2304 + 64 * (j))
#define XB_TOP      3328
#define XB_TOPGEN   3392
#define XCD_BAR_WORDS 3456
#define XB_SPIN_CAP (1u << 18)

__device__ __forceinline__ unsigned xb_ld(unsigned* p)              { return __hip_atomic_load(p, __ATOMIC_RELAXED, __HIP_MEMORY_SCOPE_AGENT); }
__device__ __forceinline__ unsigned xb_add(unsigned* p, unsigned v) { return __hip_atomic_fetch_add(p, v, __ATOMIC_RELAXED, __HIP_MEMORY_SCOPE_AGENT); }
__device__ __forceinline__ unsigned xb_xcc_id() { return (unsigned)__builtin_amdgcn_s_getreg((3 << 11) | 20) & 0xFu; }
#define XB_SPIN(cond, bar) do { unsigned _sp = 0; while (cond) { __builtin_amdgcn_s_sleep(1); \
    if ((++_sp & 255u) == 0u) { if (xb_ld(&(bar)[XB_TMO])) break; if (_sp > XB_SPIN_CAP) { atomicAdd(&(bar)[XB_TMO], 1u); break; } } } } while (0)

struct XcdBarrier { unsigned* bar; unsigned x; volatile LAS unsigned* st; };

__device__ __forceinline__ XcdBarrier xcd_barrier_post(unsigned* bar, volatile LAS unsigned* st) {
    XcdBarrier b; b.bar = bar; b.x = xb_xcc_id(); b.st = st;
    if (threadIdx.x == 0) (void)xb_add(&bar[XB_XCNT(b.x)], 1u);
    return b;
}
__device__ __forceinline__ void xcd_barrier_complete(unsigned* bar, unsigned x, unsigned& nloc, unsigned& nx) {
    const unsigned G = gridDim.x * gridDim.y * gridDim.z;
    unsigned sum, cnt, mine, sp = 0u;
    for (;;) {
        sum = 0u; cnt = 0u; mine = 0u;
#pragma unroll
        for (unsigned j = 0; j < 16; ++j) { const unsigned c = xb_ld(&bar[XB_XCNT(j)]); sum += c; cnt += (c > 0u) ? 1u : 0u; mine = (j == x) ? c : mine; }
        if (sum == G) break;
        __builtin_amdgcn_s_sleep(1);
        if ((++sp & 255u) == 0u) { if (xb_ld(&bar[XB_TMO])) break; if (sp > XB_SPIN_CAP) { atomicAdd(&bar[XB_TMO], 1u); break; } }
    }
    nloc = mine > 0u ? mine : 1u; nx = cnt > 0u ? cnt : 1u;
}
__device__ __forceinline__ void xcd_barrier(const XcdBarrier& b) {
    asm volatile("s_waitcnt vmcnt(0)" ::: "memory");
    __syncthreads();
    if (threadIdx.x == 0) {
        unsigned* bar = b.bar;
        __builtin_amdgcn_s_waitcnt(0);
        unsigned nloc = b.st[0], nx = b.st[1];
        if (nloc == 0u) { xcd_barrier_complete(bar, b.x, nloc, nx); b.st[0] = nloc; b.st[1] = nx; }
        const unsigned old = xb_add(&bar[XB_XSUB(b.x)], 1u);
        const unsigned gen = old / nloc;
        if (old + 1u == (gen + 1u) * nloc) {
            __builtin_amdgcn_fence(__ATOMIC_RELEASE, "agent");
            asm volatile("s_waitcnt vmcnt(0)" ::: "memory");
            const unsigned og = xb_add(&bar[XB_TOP], 1u);
            const unsigned tg = og / nx;
            if (og + 1u == (tg + 1u) * nx) xb_add(&bar[XB_TOPGEN], 1u);
            else XB_SPIN(xb_ld(&bar[XB_TOPGEN]) == tg, bar);
            __builtin_amdgcn_fence(__ATOMIC_ACQUIRE, "agent");
            xb_add(&bar[XB_XGEN(b.x)], 1u);
            asm volatile("s_waitcnt vmcnt(0)" ::: "memory");
        } else {
            XB_SPIN(xb_ld(&bar[XB_XGEN(b.x)]) == gen, bar);
            __builtin_amdgcn_fence(__ATOMIC_ACQUIRE, "agent");
            asm volatile("s_waitcnt vmcnt(0)" ::: "memory");
        }
    }
    __syncthreads();
}

__device__ __forceinline__ unsigned f2bf(float f) { unsigned u = __builtin_bit_cast(unsigned, f); return (u + 0x7fffu + ((u >> 16) & 1u)) >> 16; }
__device__ __forceinline__ unsigned pk2(float lo, float hi) { return f2bf(lo) | (f2bf(hi) << 16); }
__device__ __forceinline__ float wave_sum(float v) {
#pragma unroll
    for (int o = 1; o < 64; o <<= 1) v += __shfl_xor(v, o);
    return v;
}
__device__ __forceinline__ void transpose_item(const float* __restrict__ W, int N, bf16* __restrict__ WT, size_t ldt, int k0, int n0, int drow0, int dcol0, LAS float* scr, int lane, const float* __restrict__ kgain = nullptr  ) {
    f32x4 v[8];
#pragma unroll
    for (int i = 0; i < 8; ++i) v[i] = *(const GAS f32x4*)(W + (size_t)(k0 + 8 * i + (lane >> 3)) * N + n0 + 4 * (lane & 7));
#pragma unroll
    for (int i = 0; i < 8; ++i) { LAS float* d = scr + (8 * i + (lane >> 3)) * 33 + 4 * (lane & 7); const float gk = kgain ? kgain[k0 + 8 * i + (lane >> 3)] : 1.0f; d[0] = v[i].x * gk; d[1] = v[i].y * gk; d[2] = v[i].z * gk; d[3] = v[i].w * gk; }
    LDS_WAIT(); asm volatile("" ::: "memory");
    const int c = lane & 7;
#pragma unroll
    for (int j = 0; j < 4; ++j) { const int n = (lane >> 3) + 8 * j; const LAS float* s = scr + (8 * c) * 33 + n;
        v4u o; o.x = pk2(s[0 * 33], s[1 * 33]); o.y = pk2(s[2 * 33], s[3 * 33]); o.z = pk2(s[4 * 33], s[5 * 33]); o.w = pk2(s[6 * 33], s[7 * 33]);
        *(GAS v4u*)(WT + (size_t)(drow0 + n) * ldt + dcol0 + 8 * c) = o; }
    LDS_WAIT(); asm volatile("" ::: "memory");
}
__device__ __forceinline__ void tr_plain(const float* W, int N, bf16* WT, size_t ldt, int dcol0, int item, LAS float* scr, int lane, const float* kgain = nullptr) {
    const int nblk = N / 32, kb = item / nblk, nb = item % nblk;
    transpose_item(W, N, WT, ldt, 64 * kb, 32 * nb, 32 * nb, dcol0 + 64 * kb, scr, lane, kgain);
}
__device__ __forceinline__ void tr_blocked(const float* W, int N, bf16* WT, int item, LAS float* scr, int lane) {
    const int nblk = N / 32, kb = item / nblk, nb = item % nblk;
    transpose_item(W, N, WT + (size_t)(kb >> 1) * N * 128, 128, 64 * kb, 32 * nb, 32 * nb, (kb & 1) * 64, scr, lane);
}
__device__ __forceinline__ void tr_gu(const float* W, int sel, bf16* WT, int item, LAS float* scr, int lane, const float* kgain = nullptr) {
    constexpr int nblk = FF / 32; const int kb = item / nblk, nb = item % nblk, n0 = 32 * nb;
    transpose_item(W, FF, WT, DM, 64 * kb, n0, (n0 >> 7) * 256 + sel * 128 + (n0 & 127), 64 * kb, scr, lane, kgain);
}
constexpr int IT_GU = (DM / 64) * (FF / 32), IT_DN = (FF / 64) * (DM / 32), IT_IN = (DM / 64) * (INW / 32), IT_BA = (2048 / 64) * (DM / 32), IT_BB = (1024 / 64) * (DM / 32), IT_OUT = (DM / 64) * (DM / 32);

constexpr int IT_D1 = IT_IN + IT_OUT + IT_BA + IT_BB + IT_DN;
#ifndef TAIL9_ITEMS
#define TAIL9_ITEMS 22016
#endif
#ifndef TAIL1_ITEMS
#define TAIL1_ITEMS 24576
#endif
__device__ __forceinline__ void conv_deferred(int r, const float* const* in, bf16* WIN_t, bf16* WOUT, bf16* WBR, bf16* WDN, LAS float* scr, int lane) {
    if (r < IT_IN) { tr_plain(in[6], INW, WIN_t, DM, 0, r, scr, lane, in[5]  ); return; } r -= IT_IN;
    if (r < IT_OUT) { tr_plain(in[11], DM, WOUT, DM, 0, r, scr, lane); return; } r -= IT_OUT;
    if (r < IT_BA) { tr_plain(in[9], DM, WBR, YW, 0, r, scr, lane); return; } r -= IT_BA;
    if (r < IT_BB) { tr_plain(in[10], DM, WBR, YW, 2048, r, scr, lane); return; } r -= IT_BB;
    tr_blocked(in[4], DM, WDN, r, scr, lane);
}
#define TAIL_WORK(nwg_, nitems_, CALL) do { const int full_ = (nwg_) / G, extra_ = (nwg_) - full_ * G; const bool grp_ = (extra_ > 0 && extra_ < G); \
    const int nconv_ = grp_ ? (G - extra_) : G, myc_ = grp_ ? (bx - extra_) : bx; \
    if (myc_ >= 0) for (int it = myc_ * NWAVES + wave; it < (nitems_); it += nconv_ * NWAVES) { CALL; } } while (0)

__device__ __forceinline__ void rms_row_to_bf16(const float* __restrict__ xrow, const float* __restrict__ g, bf16* __restrict__ orow, int lane) {
    const GAS f32x4* xr = (const GAS f32x4*)xrow + lane;
    f32x4 v[16]; float s = 0.f;
#pragma unroll
    for (int j = 0; j < 16; ++j) { v[j] = xr[64 * j]; s += (v[j].x * v[j].x + v[j].y * v[j].y) + (v[j].z * v[j].z + v[j].w * v[j].w); }
    const float rstd = 1.0f / sqrtf(wave_sum(s) * (1.f / DM) + RMS_EPS);
    const GAS f32x4* gr = (const GAS f32x4*)g + lane;
    GAS unsigned long long* o8 = (GAS unsigned long long*)orow + lane;
#pragma unroll
    for (int j = 0; j < 16; ++j) { const f32x4 gg = gr[64 * j];
        o8[64 * j] = (unsigned long long)pk2(v[j].x * rstd * gg.x, v[j].y * rstd * gg.y) | ((unsigned long long)pk2(v[j].z * rstd * gg.z, v[j].w * rstd * gg.w) << 32); }
}
__device__ __forceinline__ void rms_row_to_f32(const float* __restrict__ xrow, const float* __restrict__ g, float* __restrict__ orow, int lane) {
    const GAS f32x4* xr = (const GAS f32x4*)xrow + lane;
    f32x4 v[16]; float s = 0.f;
#pragma unroll
    for (int j = 0; j < 16; ++j) { v[j] = xr[64 * j]; s += (v[j].x * v[j].x + v[j].y * v[j].y) + (v[j].z * v[j].z + v[j].w * v[j].w); }
    const float rstd = 1.0f / sqrtf(wave_sum(s) * (1.f / DM) + RMS_EPS);
    const GAS f32x4* gr = (const GAS f32x4*)g + lane;
    GAS f32x4* o = (GAS f32x4*)orow + lane;
#pragma unroll
    for (int j = 0; j < 16; ++j) { const f32x4 gg = gr[64 * j]; o[64 * j] = (f32x4){v[j].x * rstd * gg.x, v[j].y * rstd * gg.y, v[j].z * rstd * gg.z, v[j].w * rstd * gg.w}; }
}
template <bool OUT_BF16>
__device__ __forceinline__ void rms_row2(const float* __restrict__ xa, const float* __restrict__ xb, const float* __restrict__ g, void* __restrict__ oa, void* __restrict__ ob, int lane) {
    const GAS f32x4* ra = (const GAS f32x4*)xa + lane; const GAS f32x4* rb = (const GAS f32x4*)xb + lane;
    f32x4 va[16], vb[16]; float sa = 0.f, sb = 0.f;
#pragma unroll
    for (int j = 0; j < 16; ++j) va[j] = ra[64 * j];
#pragma unroll
    for (int j = 0; j < 16; ++j) vb[j] = rb[64 * j];
#pragma unroll
    for (int j = 0; j < 16; ++j) sa += (va[j].x * va[j].x + va[j].y * va[j].y) + (va[j].z * va[j].z + va[j].w * va[j].w);
#pragma unroll
    for (int j = 0; j < 16; ++j) sb += (vb[j].x * vb[j].x + vb[j].y * vb[j].y) + (vb[j].z * vb[j].z + vb[j].w * vb[j].w);
    const float rsa = 1.0f / sqrtf(wave_sum(sa) * (1.f / DM) + RMS_EPS), rsb = 1.0f / sqrtf(wave_sum(sb) * (1.f / DM) + RMS_EPS);
    const GAS f32x4* gr = (const GAS f32x4*)g + lane;
#pragma unroll
    for (int j = 0; j < 16; ++j) { const f32x4 gg = gr[64 * j];
        const f32x4 ya = {va[j].x * rsa * gg.x, va[j].y * rsa * gg.y, va[j].z * rsa * gg.z, va[j].w * rsa * gg.w}, yb = {vb[j].x * rsb * gg.x, vb[j].y * rsb * gg.y, vb[j].z * rsb * gg.z, vb[j].w * rsb * gg.w};
        if constexpr (OUT_BF16) { ((GAS unsigned long long*)oa + lane)[64 * j] = (unsigned long long)pk2(ya.x, ya.y) | ((unsigned long long)pk2(ya.z, ya.w) << 32);
                                  ((GAS unsigned long long*)ob + lane)[64 * j] = (unsigned long long)pk2(yb.x, yb.y) | ((unsigned long long)pk2(yb.z, yb.w) << 32); }
        else { ((GAS f32x4*)oa + lane)[64 * j] = ya; ((GAS f32x4*)ob + lane)[64 * j] = yb; } }
}
__device__ __forceinline__ unsigned q4_pack(float a, float b, float c, float d, float inv) {
    const int ia = (int)__builtin_rintf(a * inv), ib = (int)__builtin_rintf(b * inv), ic = (int)__builtin_rintf(c * inv), id = (int)__builtin_rintf(d * inv);
    return (unsigned)(ia & 0xff) | ((unsigned)(ib & 0xff) << 8) | ((unsigned)(ic & 0xff) << 16) | ((unsigned)(id & 0xff) << 24);
}
template <int NCH = 8  >
__device__ __forceinline__ void quant_row2(const bf16* __restrict__ xa, const bf16* __restrict__ xb, unsigned char* __restrict__ qa, unsigned char* __restrict__ qb, float* sa, float* sb, float mula, float mulb, int lane) {
    const GAS v4u* ra = (const GAS v4u*)xa + lane; const GAS v4u* rb = (const GAS v4u*)xb + lane;
    v4u va[NCH], vb[NCH];
#pragma unroll
    for (int j = 0; j < NCH; ++j) va[j] = ra[64 * j];
#pragma unroll
    for (int j = 0; j < NCH; ++j) vb[j] = rb[64 * j];
    float ma = 0.f, mb = 0.f;
#pragma unroll
    for (int j = 0; j < NCH; ++j) {
#pragma unroll
        for (int c = 0; c < 4; ++c) { ma = fmaxf(ma, fmaxf(__builtin_fabsf(pg8::bf_lo(va[j][c])), __builtin_fabsf(pg8::bf_hi(va[j][c])))); mb = fmaxf(mb, fmaxf(__builtin_fabsf(pg8::bf_lo(vb[j][c])), __builtin_fabsf(pg8::bf_hi(vb[j][c])))); } }
#pragma unroll
    for (int o = 1; o < 64; o <<= 1) { ma = fmaxf(ma, __shfl_xor(ma, o)); mb = fmaxf(mb, __shfl_xor(mb, o)); }
    const float sca = ma > 0.f ? ma * (1.0f / 127.0f) : 1.0f, scb = mb > 0.f ? mb * (1.0f / 127.0f) : 1.0f, ia = 1.0f / sca, ib = 1.0f / scb;
    if (lane == 0) { *sa = sca * mula; *sb = scb * mulb; }
#pragma unroll
    for (int j = 0; j < NCH; ++j) {
        const unsigned long long pa = (unsigned long long)q4_pack(pg8::bf_lo(va[j].x), pg8::bf_hi(va[j].x), pg8::bf_lo(va[j].y), pg8::bf_hi(va[j].y), ia) | ((unsigned long long)q4_pack(pg8::bf_lo(va[j].z), pg8::bf_hi(va[j].z), pg8::bf_lo(va[j].w), pg8::bf_hi(va[j].w), ia) << 32);
        const unsigned long long pb = (unsigned long long)q4_pack(pg8::bf_lo(vb[j].x), pg8::bf_hi(vb[j].x), pg8::bf_lo(vb[j].y), pg8::bf_hi(vb[j].y), ib) | ((unsigned long long)q4_pack(pg8::bf_lo(vb[j].z), pg8::bf_hi(vb[j].z), pg8::bf_lo(vb[j].w), pg8::bf_hi(vb[j].w), ib) << 32);
        ((GAS unsigned long long*)qa + lane)[64 * j] = pa; ((GAS unsigned long long*)qb + lane)[64 * j] = pb; }
}
template <int KQ>
__device__ __forceinline__ void rms_row_mixed2(const float* __restrict__ xa, const float* __restrict__ xb, const float* __restrict__ g, unsigned char* __restrict__ oa, unsigned char* __restrict__ ob, float* sa, float* sb, int lane) {
    constexpr int JQ = KQ / 256;
    const GAS f32x4* ra = (const GAS f32x4*)xa + lane; const GAS f32x4* rb = (const GAS f32x4*)xb + lane;
    f32x4 va[16], vb[16]; float s2a = 0.f, s2b = 0.f;
#pragma unroll
    for (int j = 0; j < 16; ++j) va[j] = ra[64 * j];
#pragma unroll
    for (int j = 0; j < 16; ++j) vb[j] = rb[64 * j];
#pragma unroll
    for (int j = 0; j < 16; ++j) s2a += (va[j].x * va[j].x + va[j].y * va[j].y) + (va[j].z * va[j].z + va[j].w * va[j].w);
#pragma unroll
    for (int j = 0; j < 16; ++j) s2b += (vb[j].x * vb[j].x + vb[j].y * vb[j].y) + (vb[j].z * vb[j].z + vb[j].w * vb[j].w);
    const float rsa = 1.0f / sqrtf(wave_sum(s2a) * (1.f / DM) + RMS_EPS), rsb = 1.0f / sqrtf(wave_sum(s2b) * (1.f / DM) + RMS_EPS);
    const GAS f32x4* gr = (const GAS f32x4*)g + lane;
    float ma = 0.f, mb = 0.f;
#pragma unroll
    for (int j = 0; j < 16; ++j) { const f32x4 gg = gr[64 * j];
        va[j] = (f32x4){va[j].x * rsa * gg.x, va[j].y * rsa * gg.y, va[j].z * rsa * gg.z, va[j].w * rsa * gg.w}; vb[j] = (f32x4){vb[j].x * rsb * gg.x, vb[j].y * rsb * gg.y, vb[j].z * rsb * gg.z, vb[j].w * rsb * gg.w};
        if (j < JQ) { ma = fmaxf(ma, fmaxf(fmaxf(__builtin_fabsf(va[j].x), __builtin_fabsf(va[j].y)), fmaxf(__builtin_fabsf(va[j].z), __builtin_fabsf(va[j].w))));
                      mb = fmaxf(mb, fmaxf(fmaxf(__builtin_fabsf(vb[j].x), __builtin_fabsf(vb[j].y)), fmaxf(__builtin_fabsf(vb[j].z), __builtin_fabsf(vb[j].w)))); } }
#pragma unroll
    for (int o = 1; o < 64; o <<= 1) { ma = fmaxf(ma, __shfl_xor(ma, o)); mb = fmaxf(mb, __shfl_xor(mb, o)); }
    const float sca = ma > 0.f ? ma * (1.0f / 127.0f) : 1.0f, scb = mb > 0.f ? mb * (1.0f / 127.0f) : 1.0f, ia = 1.0f / sca, ib = 1.0f / scb;
    if (lane == 0) { *sa = sca; *sb = scb; }
#pragma unroll
    for (int j = 0; j < 16; ++j) {
        if (j < JQ) { ((GAS unsigned*)oa + lane)[64 * j] = q4_pack(va[j].x, va[j].y, va[j].z, va[j].w, ia); ((GAS unsigned*)ob + lane)[64 * j] = q4_pack(vb[j].x, vb[j].y, vb[j].z, vb[j].w, ib); }
        else { ((GAS unsigned long long*)(oa - KQ) + lane)[64 * j] = (unsigned long long)pk2(va[j].x, va[j].y) | ((unsigned long long)pk2(va[j].z, va[j].w) << 32);
               ((GAS unsigned long long*)(ob - KQ) + lane)[64 * j] = (unsigned long long)pk2(vb[j].x, vb[j].y) | ((unsigned long long)pk2(vb[j].z, vb[j].w) << 32); } }
}
template <int KQ>
__device__ __forceinline__ void tr_gu_mixed(const float* W, int sel, bf16* WM, bf16* TMP, int item, LAS float* scr, int lane, const float* kgain = nullptr) {
    constexpr int nblk = FF / 32; const int kb = item / nblk, nb = item % nblk, n0 = 32 * nb, drow = (n0 >> 7) * 256 + sel * 128 + (n0 & 127);
    if (64 * kb < KQ) transpose_item(W, FF, TMP, KQ, 64 * kb, n0, drow, 64 * kb, scr, lane, kgain);
    else transpose_item(W, FF, WM, (KQ + (DM - KQ) * 2) / 2, 64 * kb, n0, drow, 64 * kb - KQ / 2, scr, lane, kgain);
}
__device__ __forceinline__ int ss_of_row(int row) { const int r = row & 255; return pg8::ss_index(row >> 8, (r >> 6) & 1, r & 15, r >> 7, (r >> 4) & 3); }
__device__ __forceinline__ void qk_norm_rope_row(bf16* __restrict__ hm, size_t m, int t, const float* __restrict__ qg, const float* __restrict__ kg, int lane) {
    const int sub = lane & 15, hq = lane >> 4;
    const int axis = sub >> 3, pos = axis ? (t & 63) : (t >> 6);
    float cs[8], sn[8];
#pragma unroll
    for (int e = 0; e < 8; ++e) { const int i = 8 * (sub & 3) + e;
        const float inv = exp2f(-(float)i * (13.287712379549449f / 32.0f));
        const float ang = (float)pos * inv; const float rev = ang * 0.15915494309189535f;
        cs[e] = __builtin_amdgcn_cosf(rev); sn[e] = __builtin_amdgcn_sinf(rev); }
    const bool lo_half = (sub & 4) == 0;
    float gq[8], gk[8];
#pragma unroll
    for (int e = 0; e < 8; ++e) { gq[e] = qg[sub * 8 + e]; gk[e] = kg[sub * 8 + e]; }
#pragma unroll
    for (int it = 0; it < 5; ++it) {
        const int head = it * 4 + hq;
        GAS v4u* p = (GAS v4u*)(hm + ((size_t)head * M + m) * HD + sub * 8);
        const v4u w = *p;
        float x[8]; x[0] = pg8::bf_lo(w.x); x[1] = pg8::bf_hi(w.x); x[2] = pg8::bf_lo(w.y); x[3] = pg8::bf_hi(w.y); x[4] = pg8::bf_lo(w.z); x[5] = pg8::bf_hi(w.z); x[6] = pg8::bf_lo(w.w); x[7] = pg8::bf_hi(w.w);
        float ss = 0.f;
#pragma unroll
        for (int e = 0; e < 8; ++e) ss += x[e] * x[e];
        ss += __shfl_xor(ss, 1); ss += __shfl_xor(ss, 2); ss += __shfl_xor(ss, 4); ss += __shfl_xor(ss, 8);
        const float rstd = 1.0f / sqrtf(ss * (1.f / HD) + RMS_EPS);
        float y[8], r[8];
#pragma unroll
        for (int e = 0; e < 8; ++e) y[e] = x[e] * rstd * (it < 4 ? gq[e] : gk[e]);
#pragma unroll
        for (int e = 0; e < 8; ++e) { const float pr = __shfl_xor(y[e], 4);
            r[e] = lo_half ? (y[e] * cs[e] - pr * sn[e]) : (pr * sn[e] + y[e] * cs[e]); }
        v4u o; o.x = pk2(r[0], r[1]); o.y = pk2(r[2], r[3]); o.z = pk2(r[4], r[5]); o.w = pk2(r[6], r[7]);
        *p = o;
    }
}
__device__ __forceinline__ void merge_row(const bf16* __restrict__ OG, const float* __restrict__ LSE, bf16* __restrict__ yrow, size_t m, int lane) {
    const int head = lane >> 3;
    float l[3];
    const size_t mg[3] = {m, (size_t)pg8::dil_row((int)m, 2), (size_t)pg8::dil_row((int)m, 4)};
#pragma unroll
    for (int g = 0; g < 3; ++g) l[g] = LSE[((size_t)g * M + mg[g]) * 8 + head];
    const float mx = fmaxf(l[0], fmaxf(l[1], l[2]));
    float e[3]; float es = 0.f;
#pragma unroll
    for (int g = 0; g < 3; ++g) { e[g] = __expf(l[g] - mx); es += e[g]; }
    const float inv = 1.0f / es;
    float acc[16];
#pragma unroll
    for (int i = 0; i < 16; ++i) acc[i] = 0.f;
#pragma unroll
    for (int g = 0; g < 3; ++g) { const float a = e[g] * inv; const GAS v4u* p = (const GAS v4u*)(OG + ((size_t)g * M + mg[g]) * 1024 + lane * 16);
#pragma unroll
        for (int h = 0; h < 2; ++h) { const v4u w = p[h];
            acc[8 * h + 0] += a * pg8::bf_lo(w.x); acc[8 * h + 1] += a * pg8::bf_hi(w.x); acc[8 * h + 2] += a * pg8::bf_lo(w.y); acc[8 * h + 3] += a * pg8::bf_hi(w.y);
            acc[8 * h + 4] += a * pg8::bf_lo(w.z); acc[8 * h + 5] += a * pg8::bf_hi(w.z); acc[8 * h + 6] += a * pg8::bf_lo(w.w); acc[8 * h + 7] += a * pg8::bf_hi(w.w); } }
    GAS v4u* o = (GAS v4u*)(yrow + lane * 16);
#pragma unroll
    for (int h = 0; h < 2; ++h) { v4u w; w.x = pk2(acc[8 * h + 0], acc[8 * h + 1]); w.y = pk2(acc[8 * h + 2], acc[8 * h + 3]); w.z = pk2(acc[8 * h + 4], acc[8 * h + 5]); w.w = pk2(acc[8 * h + 6], acc[8 * h + 7]); o[h] = w; }
}

struct Args { const float* in[17]; float* out; unsigned char* ws; int ph_lo, ph_hi; };
enum { I_X = 0, I_GFFN1, I_W1G, I_W1U, I_W1D, I_GMIX, I_WIN, I_QN, I_KN, I_WBA, I_WBB, I_WOUT, I_GFFN2, I_W2G, I_W2U, I_W2D, I_GFIN };

__global__ void __launch_bounds__(NWAVES * 64, 2) hyb_fwd(Args args) {
    extern __shared__ __attribute__((aligned(16))) unsigned char lds_raw[];
    LAS unsigned char* lds = (LAS unsigned char*)lds_raw;
    volatile LAS unsigned* MISC = (volatile LAS unsigned*)(lds + MISC_OFF);
    const int wave = __builtin_amdgcn_readfirstlane((int)threadIdx.x >> 6);
#define lane lane_id()
#define tid ((int)(wave * 64 + lane_id()))
    const int G = gridDim.x; const int bx = blockIdx.x; const int vcu = (G % 8 == 0) ? (bx % 8) * (G / 8) + bx / 8 : bx;
    unsigned char* ws = args.ws;
    gu32* ctl = (gu32*)(ws + WS_CTL);
    bf16* WGU = (bf16*)(ws + WS_WGU); bf16* WDN = (bf16*)(ws + WS_WDN); bf16* WIN_t = (bf16*)(ws + WS_WIN); bf16* WBR = (bf16*)(ws + WS_WBR); bf16* WOUT = (bf16*)(ws + WS_WOUT);
    bf16* XN = (bf16*)(ws + WS_XN); bf16* HMB = (bf16*)(ws + WS_BIG); unsigned char* GATES = (unsigned char*)(ws + WS_BIG + 384 * MiB); bf16* HID = (bf16*)(ws + WS_BIG); bf16* Y = (bf16*)(ws + WS_Y); bf16* OG = (bf16*)(ws + WS_OG); float* LSE = (float*)(ws + WS_LSE);
    float* Hs = args.out;
    for (int u = tid; u < (LDS_BYTES - LDSCTL_OFF) / 4; u += NWAVES * 64) ((LAS unsigned*)(lds + LDSCTL_OFF))[u] = 0u;
    __syncthreads();
    XcdBarrier bar = xcd_barrier_post((unsigned*)(ctl + CW_BAR), MISC + 8);
    const int lo = args.ph_lo, hi = args.ph_hi;
#define IN(k) (lo <= (k) && (k) < hi)
#define SEAM(k) do { if (IN(k) && IN((k) + 1)) xcd_barrier(bar); } while (0)
#ifndef PROBE_DUP
#define PROBE_DUP -1
#endif
#define REPS(k) ((PROBE_DUP == (k)) ? 2 : 1)
    const int gw = vcu * NWAVES + wave, NGW = G * NWAVES;
    LAS float* scr = (LAS float*)(lds + RING_OFF + wave * 16384);

    float* SS1 = (float*)(ctl + CW_SS1); float* SS2 = (float*)(ctl + CW_SS2); bf16* XN2 = (bf16*)(ws + WS_XN2);
    unsigned char* YQ = ws + WS_WIN; unsigned char* WBRQ = ws + WS_WIN + 64 * MiB; float* RSA = (float*)(ws + WS_WIN + 80 * MiB); float* CSA = RSA + M;
    if (IN(0)) for (int rep = 0; rep < REPS(0); ++rep) {
        unsigned char* XNM = (unsigned char*)XN; bf16* WGUM = WGU; bf16* TMPW = (bf16*)(ws + WS_BIG); float* RS1 = LSE; float* CS1 = LSE + M;
        constexpr int NIT = 2 * IT_GU + (IT_D1 - TAIL1_ITEMS);
        for (int it = gw; it < NIT; it += NGW) {
            int r = it;
            if (r < IT_GU) { tr_gu_mixed<KQ1>(args.in[I_W1G], 0, WGUM, TMPW, r, scr, lane); continue; } r -= IT_GU;
            if (r < IT_GU) { tr_gu_mixed<KQ1>(args.in[I_W1U], 1, WGUM, TMPW, r, scr, lane); continue; } r -= IT_GU;
            conv_deferred(TAIL1_ITEMS + r, args.in, WIN_t, WOUT, WBR, WDN, scr, lane);
        }
        for (int m = gw; m < M; m += 2 * NGW) { const int m2 = (m + NGW < M) ? m + NGW : m;
            rms_row_mixed2<KQ1>(args.in[I_X] + (size_t)m * DM, args.in[I_X] + (size_t)m2 * DM, args.in[I_GFFN1], XNM + (size_t)m * ROWB1, XNM + (size_t)m2 * ROWB1, RS1 + ss_of_row(m), RS1 + ss_of_row(m2), lane); }
        xcd_barrier(bar);
        for (int n = 2 * gw; n < 2 * FF; n += 2 * NGW)
            quant_row2<KQ1 / 512>(TMPW + (size_t)n * KQ1, TMPW + (size_t)(n + 1) * KQ1, (unsigned char*)WGUM + (size_t)n * ROWB1, (unsigned char*)WGUM + (size_t)(n + 1) * ROWB1, CS1 + n, CS1 + n + 1, 1.0f, 1.0f, lane);
    }
    SEAM(0);
    if (IN(1)) for (int rep = 0; rep < REPS(1); ++rep) {
        pg8::Gemm g{(const pg8::bf16_t*)XN, WGU, M, 2 * FF, ROWB1 / 2, ROWB1 / 2, ROWB1 / 2, 256, 256}; pg8::StaticOrder S; S.init(M, 2 * FF, G, bx);
        pg8::EpiSwiGLUQ E{{HID, M, nullptr, 0.f, 0.f}, LSE, LSE + M};
        pg8::gemm_phase<pg8::EpiSwiGLUQ, pg8::StaticOrder, true, false, KQ1 / 128>(lds + RING_OFF, g, S, E, wave);
        TAIL_WORK((M / 256) * (2 * FF / 256), TAIL1_ITEMS, conv_deferred(it, args.in, WIN_t, WOUT, WBR, WDN, scr, lane));
    }
    SEAM(1);
    if (IN(2)) {
        pg8::Gemm g{HID, WDN, M, DM, FF, 128, 128, (size_t)M * 256, (size_t)DM * 256}; pg8::BandOrder S; S.init(M, DM, G, bx);
        pg8::EpiRes<false, true, true> E{args.in[I_X], DM, XN, DM, 0.5f, SS1};
        pg8::gemm_phase<pg8::EpiRes<false, true, true>, pg8::BandOrder, true>(lds + RING_OFF, g, S, E, wave);
    }
    SEAM(2);
    if (IN(3)) for (int rep = 0; rep < REPS(3); ++rep) {
        unsigned char* XQ = (unsigned char*)(ws + WS_XN2); unsigned char* WQ = (unsigned char*)(ws + WS_WGU);
        float* RS = LSE; float* CS = LSE + M;
        { const int NR = M + INW;
          for (int r = 2 * gw; r < NR; r += 2 * NGW) {
              if (r < M) quant_row2(XN + (size_t)r * DM, XN + (size_t)(r + 1) * DM, XQ + (size_t)r * DM, XQ + (size_t)(r + 1) * DM, RS + ss_of_row(r), RS + ss_of_row(r + 1),
                                    1.0f / sqrtf(SS1[ss_of_row(r)] * (1.0f / DM) + RMS_EPS), 1.0f / sqrtf(SS1[ss_of_row(r + 1)] * (1.0f / DM) + RMS_EPS), lane);
              else { const int n = r - M; quant_row2(WIN_t + (size_t)n * DM, WIN_t + (size_t)(n + 1) * DM, WQ + (size_t)n * DM, WQ + (size_t)(n + 1) * DM, CS + n, CS + n + 1, 1.0f, 1.0f, lane); } } }
        xcd_barrier(bar);
        pg8::Gemm g{(const pg8::bf16_t*)XQ, (const pg8::bf16_t*)WQ, M, INW, DM / 2, DM / 2, DM / 2, 256, 256}; pg8::StaticOrder S; S.init(M, INW, G, bx);
        pg8::EpiBf16Q E{HMB, M, GATES, GW, RS, CS, (C_QKVB + 3072) / 256, (C_QKVB + 6144) / 256, C_GA / 256};
        pg8::gemm_phase<pg8::EpiBf16Q, pg8::StaticOrder, true, true>(lds + RING_OFF, g, S, E, wave);
    }
    SEAM(3);
    if (IN(4)) {
        for (int m = gw; m < M; m += NGW) qk_norm_rope_row(HMB, (size_t)m, m & (T - 1), args.in[I_QN], args.in[I_KN], lane);
        constexpr int NIT = 2 * IT_GU + (IT_DN - TAIL9_ITEMS);
        for (int it = gw; it < NIT; it += NGW) {
            int r = it;
            if (r < IT_GU) { tr_gu(args.in[I_W2G], 0, WGU, r, scr, lane, args.in[I_GFFN2]); continue; } r -= IT_GU;
            if (r < IT_GU) { tr_gu(args.in[I_W2U], 1, WGU, r, scr, lane, args.in[I_GFFN2]); continue; } r -= IT_GU;
            tr_blocked(args.in[I_W2D], DM, WDN, TAIL9_ITEMS + r, scr, lane);
        }
    }
    SEAM(4);
    if (IN(5)) for (int rep = 0; rep < REPS(5); ++rep) {
        LAS char* alds = (LAS char*)(lds + RING_OFF);
        for (int u = vcu; u < BATCH * 16 * 16; u += G) {
            const int qb = u & 15, h = (u >> 4) & 15, b = u >> 8, kvh = h >> 2;
            const size_t row0 = (size_t)b * T;
            att::dense_unit(HMB + ((size_t)(S_QA + h) * M + row0 + qb * 256) * HD, HMB + ((size_t)(S_KA + kvh) * M + row0) * HD, HMB + ((size_t)(S_VA + kvh) * M + row0) * HD,
                            Y + (row0 + qb * 256) * YW + h * HD, YW, T / 64, alds, wave);
        }
        for (int u = vcu; u < BATCH * 3 * 8 * 16; u += G) {
            const int sub = u & 15, h = (u >> 4) & 7, bg = u >> 7, grp = bg % 3, b = bg / 3;
            const int dsh = 2 * grp, d = 1 << dsh, L = T >> dsh, nqb = L >> 8;
            const int res = sub / nqb, i0 = (sub % nqb) * 256;
            const float slope = exp2f(-8.0f * (float)(grp * 8 + h + 1) / 24.0f);
            const size_t row0 = (size_t)b * T + (size_t)res * L;
            const int sq = S_B + grp * 24 + h;
            att::win_unit(HMB + ((size_t)sq * M + row0 + i0) * HD, HMB + ((size_t)(sq + 8) * M + row0) * HD, HMB + ((size_t)(sq + 16) * M + row0) * HD,
                          OG + ((size_t)grp * M + row0 + i0) * 1024 + h * HD, 1024, LSE + ((size_t)grp * M + row0 + i0) * 8 + h, 8, i0, L, slope * (float)d / att::SCALE, alds, wave);
        }
    }
    SEAM(5);
    if (IN(6)) {
        for (int m = gw; m < M; m += NGW) merge_row(OG, LSE, (bf16*)(YQ + (size_t)m * 4096 + 2048), (size_t)m, lane);
        for (int r = 2 * gw; r < M + DM; r += 2 * NGW) {
            if (r < M) quant_row2<4>(Y + (size_t)r * YW, Y + (size_t)(r + 1) * YW, YQ + (size_t)r * 4096, YQ + (size_t)(r + 1) * 4096, RSA + ss_of_row(r), RSA + ss_of_row(r + 1), 1.0f, 1.0f, lane);
            else { const int n = r - M;
                quant_row2<4>(WBR + (size_t)n * YW, WBR + (size_t)(n + 1) * YW, WBRQ + (size_t)n * 4096, WBRQ + (size_t)(n + 1) * 4096, CSA + n, CSA + n + 1, 1.0f, 1.0f, lane);
#pragma unroll
                for (int q = 0; q < 2; ++q) { const GAS v4u* sp = (const GAS v4u*)(WBR + (size_t)(n + q) * YW + 2048) + lane; GAS v4u* dp = (GAS v4u*)(WBRQ + (size_t)(n + q) * 4096 + 2048) + lane; dp[0] = sp[0]; dp[64] = sp[64]; } } }
    }
    SEAM(6);
    if (IN(7)) {
        pg8::Gemm g{(const pg8::bf16_t*)YQ, (const pg8::bf16_t*)WBRQ, M, DM, 2048, 2048, 2048, 256, 256}; pg8::StaticOrder S; S.init(M, DM, G, bx);
        pg8::EpiGateABQ E{{GATES, GATES + DM, GW, XN2, DM}, RSA, CSA};
        pg8::gemm_phase<pg8::EpiGateABQ, pg8::StaticOrder, true, false, 16>(lds + RING_OFF, g, S, E, wave);
    }
    SEAM(7);
    if (IN(8)) {
        unsigned char* XQ = (unsigned char*)(ws + WS_OG); unsigned char* WQ = (unsigned char*)(ws + WS_Y);
        float* RS = LSE; float* CS = LSE + M;
        { const int NR = M + DM;
          for (int r = 2 * gw; r < NR; r += 2 * NGW) {
              if (r < M) quant_row2(XN2 + (size_t)r * DM, XN2 + (size_t)(r + 1) * DM, XQ + (size_t)r * DM, XQ + (size_t)(r + 1) * DM, RS + ss_of_row(r), RS + ss_of_row(r + 1), 1.0f, 1.0f, lane);
              else { const int n = r - M; quant_row2(WOUT + (size_t)n * DM, WOUT + (size_t)(n + 1) * DM, WQ + (size_t)n * DM, WQ + (size_t)(n + 1) * DM, CS + n, CS + n + 1, 1.0f, 1.0f, lane); } } }
        xcd_barrier(bar);
        pg8::Gemm g{(const pg8::bf16_t*)XQ, (const pg8::bf16_t*)WQ, M, DM, DM / 2, DM / 2, DM / 2, 256, 256}; pg8::StaticOrder S; S.init(M, DM, G, bx);
        pg8::EpiResQ E{XN, DM, XN, DM, RS, CS, SS2};
        pg8::gemm_phase<pg8::EpiResQ, pg8::StaticOrder, true, true>(lds + RING_OFF, g, S, E, wave);
    }
    SEAM(8);
    if (IN(9)) {
        pg8::Gemm g{XN, WGU, M, 2 * FF, DM, DM, DM, 256, 256}; pg8::StaticOrder S; S.init(M, 2 * FF, G, bx);
        pg8::EpiSwiGLU E{HID, M, SS2, 1.0f / DM, RMS_EPS};
        pg8::gemm_phase<pg8::EpiSwiGLU, pg8::StaticOrder, true>(lds + RING_OFF, g, S, E, wave);
        if (TAIL9_ITEMS > 0) TAIL_WORK((M / 256) * (2 * FF / 256), TAIL9_ITEMS, tr_blocked(args.in[I_W2D], DM, WDN, it, scr, lane));
    }
    SEAM(9);
    if (IN(10)) {
        pg8::Gemm g{HID, WDN, M, DM, FF, 128, 128, (size_t)M * 256, (size_t)DM * 256}; pg8::BandOrder S; S.init(M, DM, G, bx);
        pg8::EpiRes<true, false, false> E{XN, DM, Hs, DM, 0.5f, nullptr};
        pg8::gemm_phase<pg8::EpiRes<true, false, false>, pg8::BandOrder, true>(lds + RING_OFF, g, S, E, wave);
    }
    SEAM(10);
    if (IN(11)) {
        { int m = gw;
          for (; m + NGW < M; m += 2 * NGW) rms_row2<false>(Hs + (size_t)m * DM, Hs + (size_t)(m + NGW) * DM, args.in[I_GFIN], Hs + (size_t)m * DM, Hs + (size_t)(m + NGW) * DM, lane);
          if (m < M) rms_row_to_f32(Hs + (size_t)m * DM, args.in[I_GFIN], Hs + (size_t)m * DM, lane); }
    }
#undef IN
#undef SEAM
#undef lane
#undef tid
}

#ifndef MK_PER_PHASE
#define MK_PER_PHASE 0
#endif
extern "C" void kernel_launch(void* const* d_in, const int* in_sizes, int n_in, void* d_out, int out_size, void* d_ws, size_t ws_size, hipStream_t stream) {
    static int grid = 0;
    if (grid == 0) {
        if (n_in != 17 || in_sizes[0] != M * DM || out_size != M * DM || ws_size < WS_END) {
            fprintf(stderr, "kernel_launch: shape mismatch: n_in %d in0 %d out %d ws %zu (need >= %zu); nothing launched\n", n_in, n_in > 0 ? in_sizes[0] : -1, out_size, ws_size, (size_t)WS_END); grid = -1; return; }
        int dev = 0, cus = 0, per_cu = 0;
        if (hipGetDevice(&dev) != hipSuccess || hipDeviceGetAttribute(&cus, hipDeviceAttributeMultiprocessorCount, dev) != hipSuccess) { fprintf(stderr, "kernel_launch: device query failed\n"); grid = -1; return; }
        if (hipFuncSetAttribute((const void*)hyb_fwd, hipFuncAttributeMaxDynamicSharedMemorySize, LDS_BYTES) != hipSuccess) { fprintf(stderr, "kernel_launch: hipFuncSetAttribute failed\n"); grid = -1; return; }
        if (hipOccupancyMaxActiveBlocksPerMultiprocessor(&per_cu, (const void*)hyb_fwd, NWAVES * 64, LDS_BYTES) != hipSuccess || per_cu < 1)
            fprintf(stderr, "kernel_launch: note: occupancy query reports %d workgroups per CU\n", per_cu);
        (void)hipGetLastError();
        grid = cus;
    }
    if (grid < 0) return;
    if (hipMemsetAsync((char*)d_ws + WS_CTL, 0, CTL_ZERO_BYTES, stream) != hipSuccess) { fprintf(stderr, "kernel_launch: memset failed\n"); return; }
    Args a{};
    for (int i = 0; i < 17; ++i) a.in[i] = (const float*)d_in[i];
    a.out = (float*)d_out; a.ws = (unsigned char*)d_ws;
#if MK_PER_PHASE
    for (int p = 0; p < N_PHASES; ++p) { a.ph_lo = p; a.ph_hi = p + 1; hipLaunchKernelGGL(hyb_fwd, dim3(grid), dim3(NWAVES * 64), LDS_BYTES, stream, a); }
#else
    a.ph_lo = 0; a.ph_hi = N_PHASES;
    hipLaunchKernelGGL(hyb_fwd, dim3(grid), dim3(NWAVES * 64), LDS_BYTES, stream, a);
#endif
    const hipError_t le = hipPeekAtLastError();
    if (le != hipSuccess) fprintf(stderr, "kernel_launch: launch failed: %s\n", hipGetErrorName(le));
}
```

```cpp
#include <hip/hip_runtime.h>
#include <cstdio>
#include <cstdint>

__device__ __forceinline__ int lane_id() { int l; asm volatile("v_mbcnt_lo_u32_b32 %0, -1, 0\n\tv_mbcnt_hi_u32_b32 %0, -1, %0" : "=v"(l)); return l; }
namespace pg8 {
#define PG8_LAS __attribute__((address_space(3)))
typedef unsigned short bf16_t;
typedef short bf16x8 __attribute__((ext_vector_type(8)));
typedef float f32x4 __attribute__((ext_vector_type(4)));
typedef unsigned u32x4 __attribute__((ext_vector_type(4)));
typedef int i32x4 __attribute__((ext_vector_type(4)));
template <bool I8> struct AccT { typedef f32x4 type; };
template <> struct AccT<true> { typedef i32x4 type; };
constexpr int BM = 256, BK = 64, HALF = 128, HTB = HALF * BK * 2  , STAGE_BYTES = 8 * HTB, NXCD = 8, WGM = 8;

__host__ __device__ __forceinline__ int lds_byte(int r, int c) { const int rr = r & 7, g = c >> 3; return (r >> 3) * 1024 + (rr * 8 + (g ^ (2 * (rr >> 1)))) * 16 + (c & 7) * 2; }
__host__ __device__ __forceinline__ void stage_rc(int b, int& R, int& C) { const int p = (b % 1024) / 16, rr = p >> 3, g = (p & 7) ^ (2 * (rr >> 1)); R = (b / 1024) * 8 + rr; C = g * 8 + (b % 16) / 2; }
__host__ __device__ __forceinline__ int perm32(int rho) { const int n = rho >> 4, i = rho & 15; return 8 * (i >> 2) + 4 * n + (i & 3); }

struct Unit { int pm, pn; };
struct Gemm { const bf16_t* A; const bf16_t* Bt; int M, N, K, lda, ldb; size_t kpA, kpB; };

struct StaticOrder {
    int nM, nN, nwg, G, c;
    __host__ __device__ void init(int M, int N, int G_, int c_) { nM = M / BM; nN = N / BM; nwg = nM * nN; G = G_; c = c_; }
    __host__ __device__ bool next(int i, Unit& u) const {
        const long L = (long)i * G + c; if (L >= nwg) return false;
        int wgid = (int)L; { const int q = nwg / NXCD, r = nwg % NXCD, xcd = wgid % NXCD, off = wgid / NXCD; wgid = (xcd < r ? xcd * (q + 1) : r * (q + 1) + (xcd - r) * q) + off; }
        const int nig = WGM * nN, gid = wgid / nig, fm = gid * WGM, gsz = (nM - fm) < WGM ? (nM - fm) : WGM;
        u.pm = fm + ((wgid % nig) % gsz); u.pn = (wgid % nig) / gsz; return true;
    }
    __device__ __forceinline__ void a_ready(const Unit&) const {}
    __device__ __forceinline__ void done(const Unit&) const {}
};

struct BandOrder {
    StaticOrder so; int G, c;
    __host__ __device__ void init(int M, int N, int G_, int c_) { so.init(M, N, G_, c_); G = G_; c = c_; }
    __host__ __device__ bool next(int i, Unit& u) const {
        if (G != 256 || so.nM != 64 || so.nN != 16) return so.next(i, u);
        if (i >= 4) return false;
        const int x = c & 7, j = c >> 3;
        u.pm = 16 * i + 4 * (x & 3) + (j & 3); u.pn = 8 * (x >> 2) + (j >> 2); return true;
    }
    __device__ __forceinline__ void a_ready(const Unit&) const {}
    __device__ __forceinline__ void done(const Unit&) const {}
};

__device__ __forceinline__ unsigned cvt_pk_bf16(float lo, float hi) { unsigned r; asm volatile("v_cvt_pk_bf16_f32 %0, %1, %2" : "=v"(r) : "v"(lo), "v"(hi)); return r; }
__device__ __forceinline__ float bf_lo(unsigned w) { return __uint_as_float(w << 16); }
__device__ __forceinline__ float bf_hi(unsigned w) { return __uint_as_float(w & 0xffff0000u); }
__device__ __forceinline__ float sigmoid_f(float x) { return __builtin_amdgcn_rcpf(1.0f + __builtin_amdgcn_exp2f(-1.4426950408889634f * x)); }

__device__ __forceinline__ int ss_index(int pm, int wr, int fr, int ai, int m) { return pm * 256 + wr * 128 + fr * 8 + ai * 4 + m; }
__device__ __forceinline__ void load_rstd8(const float* ss, int pm, int wr, int fr, float inv_n, float eps, float (&sc)[2][4]) {
    const f32x4 a = *(const f32x4*)(ss + ss_index(pm, wr, fr, 0, 0)), b = *(const f32x4*)(ss + ss_index(pm, wr, fr, 1, 0));
#pragma unroll
    for (int m = 0; m < 4; ++m) { sc[0][m] = __builtin_amdgcn_rsqf(a[m] * inv_n + eps); sc[1][m] = __builtin_amdgcn_rsqf(b[m] * inv_n + eps); }
}
__host__ __device__ __forceinline__ int dil_row(int row, int dsh) { const int t = row & 4095; return (row & ~4095) | ((t & ((1 << dsh) - 1)) << (12 - dsh)) | (t >> dsh); }
struct EpiBf16 {
    static constexpr bool PERM = true, AFTER_DRAIN = false;
    bf16_t* HM; int nrows; unsigned char* G; int ldg; const float* ss; float inv_n, eps; int pn_d4, pn_d16, pn_gate;
    __device__ __forceinline__ void operator()(const f32x4 (&acc)[2][2][4][2], const Unit& u, int wr, int wc, int fr, int fq) const {
        const int row0 = u.pm * BM + wr * 64 + fr, cw = wc * 32 + 8 * fq;
        const bool is_gate = u.pn >= pn_gate;
        const int dsh = (u.pn >= pn_d4 && !is_gate) ? (u.pn >= pn_d16 ? 4 : 2) : 0;
        float scv[2][4];
        load_rstd8(ss, u.pm, wr, fr, inv_n, eps, scv);
#pragma unroll
        for (int ai = 0; ai < 2; ++ai)
#pragma unroll
            for (int m = 0; m < 4; ++m) { const int row = row0 + ai * HALF + m * 16; const float sc = scv[ai][m];
#pragma unroll
                for (int bj = 0; bj < 2; ++bj) { const f32x4 v0 = acc[ai][bj][m][0] * sc, v1 = acc[ai][bj][m][1] * sc;
                    if (is_gate) {
                        unsigned q[8];
#pragma unroll
                        for (int e = 0; e < 4; ++e) { q[e] = (unsigned)(sigmoid_f(v0[e]) * 255.0f + 0.5f); q[4 + e] = (unsigned)(sigmoid_f(v1[e]) * 255.0f + 0.5f); }
                        const unsigned long long pk = (unsigned long long)(q[0] | (q[1] << 8) | (q[2] << 16) | (q[3] << 24)) | ((unsigned long long)(q[4] | (q[5] << 8) | (q[6] << 16) | (q[7] << 24)) << 32);
                        *(unsigned long long*)(G + (size_t)row * ldg + (u.pn - pn_gate) * BM + bj * HALF + cw) = pk;
                    } else {
                        u32x4 w; w.x = cvt_pk_bf16(v0[0], v0[1]); w.y = cvt_pk_bf16(v0[2], v0[3]); w.z = cvt_pk_bf16(v1[0], v1[1]); w.w = cvt_pk_bf16(v1[2], v1[3]);
                        *(u32x4*)(HM + ((size_t)(2 * u.pn + bj) * nrows + dil_row(row, dsh)) * HALF + cw) = w; } } }
    }
};
struct EpiBf16Q {
    static constexpr bool PERM = true, AFTER_DRAIN = false;
    bf16_t* HM; int nrows; unsigned char* G; int ldg; const float* rs; const float* cs; int pn_d4, pn_d16, pn_gate;
    __device__ __forceinline__ void operator()(const i32x4 (&acc)[2][2][4][2], const Unit& u, int wr, int wc, int fr, int fq) const {
        const int row0 = u.pm * BM + wr * 64 + fr, cw = wc * 32 + 8 * fq;
        const bool is_gate = u.pn >= pn_gate;
        const int dsh = (u.pn >= pn_d4 && !is_gate) ? (u.pn >= pn_d16 ? 4 : 2) : 0;
        float scv[2][4];
        { const f32x4 a = *(const f32x4*)(rs + ss_index(u.pm, wr, fr, 0, 0)), b = *(const f32x4*)(rs + ss_index(u.pm, wr, fr, 1, 0));
#pragma unroll
          for (int m = 0; m < 4; ++m) { scv[0][m] = a[m]; scv[1][m] = b[m]; } }
        f32x4 cc[2][2];
#pragma unroll
        for (int bj = 0; bj < 2; ++bj) { const float* cp = cs + u.pn * BM + bj * HALF + cw; cc[bj][0] = *(const f32x4*)cp; cc[bj][1] = *(const f32x4*)(cp + 4); }
#pragma unroll
        for (int ai = 0; ai < 2; ++ai)
#pragma unroll
            for (int m = 0; m < 4; ++m) { const int row = row0 + ai * HALF + m * 16; const float sc = scv[ai][m];
#pragma unroll
                for (int bj = 0; bj < 2; ++bj) { const i32x4 i0 = acc[ai][bj][m][0], i1 = acc[ai][bj][m][1];
                    const f32x4 v0 = (f32x4){(float)i0[0], (float)i0[1], (float)i0[2], (float)i0[3]} * cc[bj][0] * sc, v1 = (f32x4){(float)i1[0], (float)i1[1], (float)i1[2], (float)i1[3]} * cc[bj][1] * sc;
                    if (is_gate) {
                        unsigned q[8];
#pragma unroll
                        for (int e = 0; e < 4; ++e) { q[e] = (unsigned)(sigmoid_f(v0[e]) * 255.0f + 0.5f); q[4 + e] = (unsigned)(sigmoid_f(v1[e]) * 255.0f + 0.5f); }
                        const unsigned long long pk = (unsigned long long)(q[0] | (q[1] << 8) | (q[2] << 16) | (q[3] << 24)) | ((unsigned long long)(q[4] | (q[5] << 8) | (q[6] << 16) | (q[7] << 24)) << 32);
                        *(unsigned long long*)(G + (size_t)row * ldg + (u.pn - pn_gate) * BM + bj * HALF + cw) = pk;
                    } else {
                        u32x4 w; w.x = cvt_pk_bf16(v0[0], v0[1]); w.y = cvt_pk_bf16(v0[2], v0[3]); w.z = cvt_pk_bf16(v1[0], v1[1]); w.w = cvt_pk_bf16(v1[2], v1[3]);
                        *(u32x4*)(HM + ((size_t)(2 * u.pn + bj) * nrows + dil_row(row, dsh)) * HALF + cw) = w; } } }
    }
};
struct EpiSwiGLU {
    static constexpr bool PERM = true, AFTER_DRAIN = false;
    bf16_t* O; int nrows; const float* ss; float inv_n, eps;
    __device__ __forceinline__ void operator()(const f32x4 (&acc)[2][2][4][2], const Unit& u, int wr, int wc, int fr, int fq) const {
        const int row0 = u.pm * BM + wr * 64 + fr, col0 = wc * 32 + 8 * fq;
        bf16_t* Ob = O + (size_t)u.pn * nrows * HALF;
        float scv[2][4];
        if (ss) load_rstd8(ss, u.pm, wr, fr, inv_n, eps, scv);
#pragma unroll
        for (int ai = 0; ai < 2; ++ai)
#pragma unroll
            for (int m = 0; m < 4; ++m) { const int row = row0 + ai * HALF + m * 16; bf16_t* rowp = Ob + (size_t)row * HALF + col0;
                const float sc = ss ? scv[ai][m] : 1.0f;
                float h[8];
#pragma unroll
                for (int n = 0; n < 2; ++n)
#pragma unroll
                    for (int e = 0; e < 4; ++e) { const float g = acc[ai][0][m][n][e] * sc, up = acc[ai][1][m][n][e] * sc; h[4 * n + e] = g * sigmoid_f(g) * up; }
                u32x4 w; w.x = cvt_pk_bf16(h[0], h[1]); w.y = cvt_pk_bf16(h[2], h[3]); w.z = cvt_pk_bf16(h[4], h[5]); w.w = cvt_pk_bf16(h[6], h[7]);
                *(u32x4*)rowp = w; }
    }
};
struct EpiSwiGLUQ {
    static constexpr bool PERM = true, AFTER_DRAIN = false;
    EpiSwiGLU base; const float* rs; const float* cs;
    __device__ __forceinline__ void mid(f32x4 (&acc)[2][2][4][2], const Unit& u, int wr, int wc, int fr, int fq) const {
        const int col0 = u.pn * BM + wc * 32 + 8 * fq;
        f32x4 cc[2][2];
#pragma unroll
        for (int bj = 0; bj < 2; ++bj) { const float* cp = cs + col0 + bj * HALF; cc[bj][0] = *(const f32x4*)cp; cc[bj][1] = *(const f32x4*)(cp + 4); }
#pragma unroll
        for (int ai = 0; ai < 2; ++ai) { const f32x4 rsv = *(const f32x4*)(rs + ss_index(u.pm, wr, fr, ai, 0));
#pragma unroll
            for (int m = 0; m < 4; ++m)
#pragma unroll
                for (int bj = 0; bj < 2; ++bj)
#pragma unroll
                    for (int n = 0; n < 2; ++n)
#pragma unroll
                        for (int e = 0; e < 4; ++e) acc[ai][bj][m][n][e] = (float)__float_as_int(acc[ai][bj][m][n][e]) * (rsv[m] * cc[bj][n][e]); }
    }
    __device__ __forceinline__ void operator()(const f32x4 (&acc)[2][2][4][2], const Unit& u, int wr, int wc, int fr, int fq) const { base(acc, u, wr, wc, fr, fq); }
};
template <bool RES_BF16, bool OUT_BF16, bool STATS> struct EpiRes {
    static constexpr bool PERM = true, AFTER_DRAIN = false;
    const void* res; int ldr; void* out; int ldo; float alpha; float* ss;
    __device__ __forceinline__ void operator()(const f32x4 (&acc)[2][2][4][2], const Unit& u, int wr, int wc, int fr, int fq) const {
        const int row0 = u.pm * BM + wr * 64 + fr, col0 = u.pn * BM + wc * 32 + 8 * fq;
#pragma unroll
        for (int ai = 0; ai < 2; ++ai) {
            f32x4 rf[4][2][2]; u32x4 rb[4][2];
#pragma unroll
            for (int m = 0; m < 4; ++m) { const size_t ro = (size_t)(row0 + ai * HALF + m * 16) * ldr + col0;
#pragma unroll
                for (int bj = 0; bj < 2; ++bj) {
                    if constexpr (RES_BF16) rb[m][bj] = *(const u32x4*)((const bf16_t*)res + ro + bj * HALF);
                    else { rf[m][bj][0] = *(const f32x4*)((const float*)res + ro + bj * HALF); rf[m][bj][1] = *(const f32x4*)((const float*)res + ro + bj * HALF + 4); } } }
            __builtin_amdgcn_sched_barrier(0);
#pragma unroll
            for (int m = 0; m < 4; ++m) { const int row = row0 + ai * HALF + m * 16; const size_t oo = (size_t)row * ldo + col0;
                float sq = 0.f;
#pragma unroll
                for (int bj = 0; bj < 2; ++bj) { f32x4 r0, r1;
                    if constexpr (RES_BF16) { const u32x4 w = rb[m][bj]; r0 = (f32x4){bf_lo(w.x), bf_hi(w.x), bf_lo(w.y), bf_hi(w.y)}; r1 = (f32x4){bf_lo(w.z), bf_hi(w.z), bf_lo(w.w), bf_hi(w.w)}; }
                    else { r0 = rf[m][bj][0]; r1 = rf[m][bj][1]; }
                    const f32x4 h0 = r0 + acc[ai][bj][m][0] * alpha, h1 = r1 + acc[ai][bj][m][1] * alpha;
                    if constexpr (STATS) sq += ((h0[0] * h0[0] + h0[1] * h0[1]) + (h0[2] * h0[2] + h0[3] * h0[3])) + ((h1[0] * h1[0] + h1[1] * h1[1]) + (h1[2] * h1[2] + h1[3] * h1[3]));
                    if constexpr (OUT_BF16) { u32x4 w; w.x = cvt_pk_bf16(h0[0], h0[1]); w.y = cvt_pk_bf16(h0[2], h0[3]); w.z = cvt_pk_bf16(h1[0], h1[1]); w.w = cvt_pk_bf16(h1[2], h1[3]);
                        *(u32x4*)((bf16_t*)out + oo + bj * HALF) = w; }
                    else { *(f32x4*)((float*)out + oo + bj * HALF) = h0; *(f32x4*)((float*)out + oo + bj * HALF + 4) = h1; } }
                if constexpr (STATS) { sq += __shfl_xor(sq, 16); sq += __shfl_xor(sq, 32);
                    if (fq == 0) __hip_atomic_fetch_add(ss + ss_index(u.pm, wr, fr, ai, m), sq, __ATOMIC_RELAXED, __HIP_MEMORY_SCOPE_AGENT); } }
            __builtin_amdgcn_sched_barrier(0);
        }
    }
};
struct EpiResQ {
    static constexpr bool PERM = true, AFTER_DRAIN = false;
    const bf16_t* res; int ldr; bf16_t* out; int ldo; const float* rs; const float* cs; float* ss;
    __device__ __forceinline__ void operator()(const i32x4 (&acc)[2][2][4][2], const Unit& u, int wr, int wc, int fr, int fq) const {
        const int row0 = u.pm * BM + wr * 64 + fr, col0 = u.pn * BM + wc * 32 + 8 * fq;
        f32x4 cc[2][2];
#pragma unroll
        for (int bj = 0; bj < 2; ++bj) { const float* cp = cs + col0 + bj * HALF; cc[bj][0] = *(const f32x4*)cp; cc[bj][1] = *(const f32x4*)(cp + 4); }
#pragma unroll
        for (int ai = 0; ai < 2; ++ai) {
            u32x4 rb[4][2];
            const f32x4 rsv = *(const f32x4*)(rs + ss_index(u.pm, wr, fr, ai, 0));
#pragma unroll
            for (int m = 0; m < 4; ++m) { const size_t ro = (size_t)(row0 + ai * HALF + m * 16) * ldr + col0;
#pragma unroll
                for (int bj = 0; bj < 2; ++bj) rb[m][bj] = *(const u32x4*)(res + ro + bj * HALF); }
            __builtin_amdgcn_sched_barrier(0);
#pragma unroll
            for (int m = 0; m < 4; ++m) { const int row = row0 + ai * HALF + m * 16; const size_t oo = (size_t)row * ldo + col0; const float sc = rsv[m];
                float sq = 0.f;
#pragma unroll
                for (int bj = 0; bj < 2; ++bj) { const u32x4 w = rb[m][bj];
                    const f32x4 r0 = (f32x4){bf_lo(w.x), bf_hi(w.x), bf_lo(w.y), bf_hi(w.y)}, r1 = (f32x4){bf_lo(w.z), bf_hi(w.z), bf_lo(w.w), bf_hi(w.w)};
                    const i32x4 i0 = acc[ai][bj][m][0], i1 = acc[ai][bj][m][1];
                    const f32x4 h0 = r0 + (f32x4){(float)i0[0], (float)i0[1], (float)i0[2], (float)i0[3]} * cc[bj][0] * sc, h1 = r1 + (f32x4){(float)i1[0], (float)i1[1], (float)i1[2], (float)i1[3]} * cc[bj][1] * sc;
                    sq += ((h0[0] * h0[0] + h0[1] * h0[1]) + (h0[2] * h0[2] + h0[3] * h0[3])) + ((h1[0] * h1[0] + h1[1] * h1[1]) + (h1[2] * h1[2] + h1[3] * h1[3]));
                    u32x4 o; o.x = cvt_pk_bf16(h0[0], h0[1]); o.y = cvt_pk_bf16(h0[2], h0[3]); o.z = cvt_pk_bf16(h1[0], h1[1]); o.w = cvt_pk_bf16(h1[2], h1[3]);
                    *(u32x4*)(out + oo + bj * HALF) = o; }
                sq += __shfl_xor(sq, 16); sq += __shfl_xor(sq, 32);
                if (fq == 0) __hip_atomic_fetch_add(ss + ss_index(u.pm, wr, fr, ai, m), sq, __ATOMIC_RELAXED, __HIP_MEMORY_SCOPE_AGENT); }
            __builtin_amdgcn_sched_barrier(0);
        }
    }
};
struct EpiGateAB {
    static constexpr bool PERM = true, AFTER_DRAIN = false; static constexpr int MIDT = 32;
    const unsigned char* sigA; const unsigned char* sigB; int ldg; bf16_t* O; int ldc;
    __device__ __forceinline__ void mid(f32x4 (&acc)[2][2][4][2], const Unit& u, int wr, int wc, int fr, int fq) const {
        const int row0 = u.pm * BM + wr * 64 + fr, col0 = u.pn * BM + wc * 32 + 8 * fq;
#pragma unroll
        for (int ai = 0; ai < 2; ++ai) {
            unsigned long long ga[4][2], gb[4][2];
#pragma unroll
            for (int m = 0; m < 4; ++m) { const size_t ro = (size_t)(row0 + ai * HALF + m * 16) * ldg + col0;
#pragma unroll
                for (int bj = 0; bj < 2; ++bj) { ga[m][bj] = *(const unsigned long long*)(sigA + ro + bj * HALF); gb[m][bj] = *(const unsigned long long*)(sigB + ro + bj * HALF); } }
            __builtin_amdgcn_sched_barrier(0);
#pragma unroll
            for (int m = 0; m < 4; ++m)
#pragma unroll
                for (int bj = 0; bj < 2; ++bj) { const unsigned alo = (unsigned)ga[m][bj], ahi = (unsigned)(ga[m][bj] >> 32), blo = (unsigned)gb[m][bj], bhi = (unsigned)(gb[m][bj] >> 32);
#pragma unroll
                    for (int e = 0; e < 4; ++e) { const unsigned b0 = (blo >> (8 * e)) & 0xffu, b1 = (bhi >> (8 * e)) & 0xffu;
                        acc[ai][bj][m][0][e] *= (float)((alo >> (8 * e)) & 0xffu) * __builtin_amdgcn_rcpf((float)(b0 ? b0 : 1u));
                        acc[ai][bj][m][1][e] *= (float)((ahi >> (8 * e)) & 0xffu) * __builtin_amdgcn_rcpf((float)(b1 ? b1 : 1u)); } }
            __builtin_amdgcn_sched_barrier(0);
        }
    }
    __device__ __forceinline__ void operator()(const f32x4 (&acc)[2][2][4][2], const Unit& u, int wr, int wc, int fr, int fq) const {
        const int row0 = u.pm * BM + wr * 64 + fr, col0 = u.pn * BM + wc * 32 + 8 * fq;
        unsigned long long gb[2][4][2];
#pragma unroll
        for (int ai = 0; ai < 2; ++ai)
#pragma unroll
            for (int m = 0; m < 4; ++m) { const size_t ro = (size_t)(row0 + ai * HALF + m * 16) * ldg + col0;
#pragma unroll
                for (int bj = 0; bj < 2; ++bj) gb[ai][m][bj] = *(const unsigned long long*)(sigB + ro + bj * HALF); }
        __builtin_amdgcn_sched_barrier(0);
#pragma unroll
        for (int ai = 0; ai < 2; ++ai)
#pragma unroll
            for (int m = 0; m < 4; ++m) { const size_t row = (size_t)(row0 + ai * HALF + m * 16);
#pragma unroll
                for (int bj = 0; bj < 2; ++bj) { const unsigned blo = (unsigned)gb[ai][m][bj], bhi = (unsigned)(gb[ai][m][bj] >> 32);
                    float r[8];
#pragma unroll
                    for (int e = 0; e < 4; ++e) { const unsigned b0 = (blo >> (8 * e)) & 0xffu, b1 = (bhi >> (8 * e)) & 0xffu;
                        r[e] = acc[ai][bj][m][0][e] * ((float)(b0 ? b0 : 1u) * (1.0f / 255.0f)); r[4 + e] = acc[ai][bj][m][1][e] * ((float)(b1 ? b1 : 1u) * (1.0f / 255.0f)); }
                    u32x4 w; w.x = cvt_pk_bf16(r[0], r[1]); w.y = cvt_pk_bf16(r[2], r[3]); w.z = cvt_pk_bf16(r[4], r[5]); w.w = cvt_pk_bf16(r[6], r[7]);
                    *(u32x4*)(O + row * ldc + col0 + bj * HALF) = w; } }
    }
};
struct EpiGateABQ {
    static constexpr bool PERM = true, AFTER_DRAIN = false; static constexpr int MIDT = 16;
    EpiGateAB base; const float* rs; const float* cs;
    __device__ __forceinline__ void mid(f32x4 (&acc)[2][2][4][2], const Unit& u, int wr, int wc, int fr, int fq) const {
        const int row0 = u.pm * BM + wr * 64 + fr, col0 = u.pn * BM + wc * 32 + 8 * fq;
        f32x4 cc[2][2];
#pragma unroll
        for (int bj = 0; bj < 2; ++bj) { const float* cp = cs + col0 + bj * HALF; cc[bj][0] = *(const f32x4*)cp; cc[bj][1] = *(const f32x4*)(cp + 4); }
#pragma unroll
        for (int ai = 0; ai < 2; ++ai) {
            unsigned long long ga[4][2], gb[4][2];
            const f32x4 rsv = *(const f32x4*)(rs + ss_index(u.pm, wr, fr, ai, 0));
#pragma unroll
            for (int m = 0; m < 4; ++m) { const size_t ro = (size_t)(row0 + ai * HALF + m * 16) * base.ldg + col0;
#pragma unroll
                for (int bj = 0; bj < 2; ++bj) { ga[m][bj] = *(const unsigned long long*)(base.sigA + ro + bj * HALF); gb[m][bj] = *(const unsigned long long*)(base.sigB + ro + bj * HALF); } }
            __builtin_amdgcn_sched_barrier(0);
#pragma unroll
            for (int m = 0; m < 4; ++m)
#pragma unroll
                for (int bj = 0; bj < 2; ++bj) { const unsigned alo = (unsigned)ga[m][bj], ahi = (unsigned)(ga[m][bj] >> 32), blo = (unsigned)gb[m][bj], bhi = (unsigned)(gb[m][bj] >> 32);
#pragma unroll
                    for (int e = 0; e < 4; ++e) { const unsigned b0 = (blo >> (8 * e)) & 0xffu, b1 = (bhi >> (8 * e)) & 0xffu;
                        acc[ai][bj][m][0][e] = (float)__float_as_int(acc[ai][bj][m][0][e]) * (rsv[m] * cc[bj][0][e]) * ((float)((alo >> (8 * e)) & 0xffu) * __builtin_amdgcn_rcpf((float)(b0 ? b0 : 1u)));
                        acc[ai][bj][m][1][e] = (float)__float_as_int(acc[ai][bj][m][1][e]) * (rsv[m] * cc[bj][1][e]) * ((float)((ahi >> (8 * e)) & 0xffu) * __builtin_amdgcn_rcpf((float)(b1 ? b1 : 1u))); } }
            __builtin_amdgcn_sched_barrier(0);
        }
    }
    __device__ __forceinline__ void operator()(const f32x4 (&acc)[2][2][4][2], const Unit& u, int wr, int wc, int fr, int fq) const { base(acc, u, wr, wc, fr, fq); }
};
template <class E> struct has_mid { static constexpr int value = 0; };
template <> struct has_mid<EpiGateAB> { static constexpr int value = EpiGateAB::MIDT; };

template <bool I8> __device__ __forceinline__ typename AccT<I8>::type pg8_mma(bf16x8 b, bf16x8 a, typename AccT<I8>::type c) {
    if constexpr (I8) return __builtin_amdgcn_mfma_i32_16x16x64_i8(__builtin_bit_cast(i32x4, b), __builtin_bit_cast(i32x4, a), c, 0, 0, 0);
    else return __builtin_amdgcn_mfma_f32_16x16x32_bf16(b, a, c, 0, 0, 0);
}
template <class Epi, class Sched, bool ALIGN_EPI = false, bool I8 = false  ,
          int MIXT = 0  >
__device__ __forceinline__ void gemm_phase(PG8_LAS unsigned char* lds, const Gemm g, const Sched& S, const Epi& E, const int wid  ) {
    const int lane = lane_id(), tid = wid * 64 + lane, wr = wid >> 2, wc = wid & 3, fr = lane & 15, fq = lane >> 4;
    const int K = g.K, nt = K / BK;
    const __amdgpu_buffer_rsrc_t rA = __builtin_amdgcn_make_buffer_rsrc((void*)g.A, 0, 0x7fffffff, 0x00020000), rB = __builtin_amdgcn_make_buffer_rsrc((void*)g.Bt, 0, 0x7fffffff, 0x00020000);
    unsigned voffA[2], voffB[2];
#pragma unroll
    for (int i = 0; i < 2; ++i) { int R, C; stage_rc(tid * 16 + i * 8192, R, C); const int Rb = Epi::PERM ? ((R & ~31) + perm32(R & 31)) : R;
        voffA[i] = (unsigned)(R * g.lda + C) * 2u; voffB[i] = (unsigned)(Rb * g.ldb + C) * 2u; }
    const unsigned kstep = (unsigned)(BK * 2);
    const unsigned hstepA = (unsigned)HALF * g.lda * 2u, hstepB = (unsigned)HALF * g.ldb * 2u;
    const unsigned tstepA = 2 * hstepA, tstepB = 2 * hstepB;
    const unsigned kpA = (unsigned)g.kpA, kpB = (unsigned)g.kpB;
    const unsigned ldsw = (unsigned)wid * 1024u;
    const int aoff[2] = {lds_byte(wr * 64 + fr, fq * 8), lds_byte(wr * 64 + fr, 32 + fq * 8)}, boff[2] = {lds_byte(wc * 32 + fr, fq * 8), lds_byte(wc * 32 + fr, 32 + fq * 8)};
#define PG8_SA(b, h) (((b) * 2 + (h)) * HTB)
#define PG8_SB(b, h) ((4 + (b) * 2 + (h)) * HTB)
#define PG8_STAGE(bufoff, rsrc, soff, voff) do { _Pragma("unroll") for (int _i = 0; _i < 2; ++_i) \
        __builtin_amdgcn_raw_ptr_buffer_load_lds(rsrc, (PG8_LAS void*)(lds + (bufoff) + ldsw + _i * 8192), 16, (voff)[_i], (soff), 0, 0); } while (0)
#define PG8_LDA(dst, b, h) do { _Pragma("unroll") for (int m = 0; m < 4; ++m) _Pragma("unroll") for (int k = 0; k < 2; ++k) dst[m][k] = *(const PG8_LAS bf16x8*)(lds + PG8_SA(b, h) + aoff[k] + m * 2048); } while (0)
#define PG8_LDB(dst, b, h) do { _Pragma("unroll") for (int n = 0; n < 2; ++n) _Pragma("unroll") for (int k = 0; k < 2; ++k) dst[n][k] = *(const PG8_LAS bf16x8*)(lds + PG8_SB(b, h) + boff[k] + n * 2048); } while (0)
#define PG8_MMA(ai, bj, At, Bt) do { __builtin_amdgcn_s_setprio(1); _Pragma("unroll") for (int m = 0; m < 4; ++m) _Pragma("unroll") for (int n = 0; n < 2; ++n) _Pragma("unroll") for (int k = 0; k < 2; ++k) \
        acc[ai][bj][m][n] = pg8_mma<I8>(Bt[n][k], At[m][k], acc[ai][bj][m][n]); __builtin_amdgcn_s_setprio(0); } while (0)
#define PG8_MMA_Q(ai, bj, At, Bt) do { __builtin_amdgcn_s_setprio(1); _Pragma("unroll") for (int m = 0; m < 4; ++m) _Pragma("unroll") for (int n = 0; n < 2; ++n) _Pragma("unroll") for (int k = 0; k < 2; ++k) \
        acc[ai][bj][m][n] = __builtin_bit_cast(acc_t, __builtin_amdgcn_mfma_i32_16x16x64_i8(__builtin_bit_cast(i32x4, Bt[n][k]), __builtin_bit_cast(i32x4, At[m][k]), __builtin_bit_cast(i32x4, acc[ai][bj][m][n]), 0, 0, 0)); __builtin_amdgcn_s_setprio(0); } while (0)
#define PG8_WAIT_V(n) asm volatile("s_waitcnt vmcnt(" #n ")" ::: "memory")
#define PG8_WAIT_L(n) asm volatile("s_waitcnt lgkmcnt(" #n ")" ::: "memory")
#define PG8_BAR __builtin_amdgcn_s_barrier()
#define PG8_SCHED __builtin_amdgcn_sched_barrier(0)
    Unit cur, nxt; int ui = 0;
    if (!S.next(0, cur)) return;
    typedef typename AccT<I8>::type acc_t;
    acc_t acc[2][2][4][2];
#pragma unroll
    for (int a = 0; a < 2; ++a)
#pragma unroll
        for (int b = 0; b < 2; ++b)
#pragma unroll
            for (int m = 0; m < 4; ++m)
#pragma unroll
                for (int n = 0; n < 2; ++n) acc[a][b][m][n] = (acc_t)(0);
    bf16x8 At[4][2], B0[2][2], B1[2][2];
    unsigned cA = (unsigned)cur.pm * tstepA, cB = (unsigned)cur.pn * tstepB;
    S.a_ready(cur);
    PG8_STAGE(PG8_SB(0, 0), rB, cB, voffB); PG8_STAGE(PG8_SB(0, 1), rB, cB + hstepB, voffB); PG8_STAGE(PG8_SA(0, 0), rA, cA, voffA); PG8_STAGE(PG8_SA(0, 1), rA, cA + hstepA, voffA);
    if (wr == 1) PG8_BAR;
    PG8_WAIT_V(2); PG8_BAR;
    PG8_STAGE(PG8_SB(1, 0), rB, cB + kstep, voffB); PG8_STAGE(PG8_SA(1, 0), rA, cA + kstep, voffA); PG8_STAGE(PG8_SB(1, 1), rB, cB + hstepB + kstep, voffB);
    PG8_WAIT_V(6); PG8_BAR;
    for (;;) {
        const bool has_next = S.next(ui + 1, nxt);
        const unsigned nA = has_next ? (unsigned)nxt.pm * tstepA : cA, nB = has_next ? (unsigned)nxt.pn * tstepB : cB;
#define PG8_KSTEP(MM) do { \
            const bool last = (t == nt - 2); \
            const unsigned a1 = cA + (unsigned)(t >> 1) * kpA + kstep; \
            const unsigned a2 = last ? nA : cA + (unsigned)((t >> 1) + 1) * kpA, b2 = last ? nB : cB + (unsigned)((t >> 1) + 1) * kpB; \
            const unsigned a3 = a2 + kstep, b3 = b2 + kstep; \
            if (last && has_next) S.a_ready(nxt); \
            PG8_LDB(B0, 0, 0); PG8_LDB(B1, 0, 1); PG8_SCHED; PG8_LDA(At, 0, 0); PG8_STAGE(PG8_SA(1, 1), rA, a1 + hstepA, voffA); \
            PG8_WAIT_V(8); PG8_WAIT_L(0); PG8_BAR; MM(0, 0, At, B0); MM(0, 1, At, B1); PG8_BAR; PG8_SCHED; \
            PG8_LDA(At, 0, 1); PG8_STAGE(PG8_SB(0, 0), rB, b2, voffB); PG8_STAGE(PG8_SB(0, 1), rB, b2 + hstepB, voffB); PG8_STAGE(PG8_SA(0, 0), rA, a2, voffA); \
            PG8_WAIT_V(8); PG8_WAIT_L(0); PG8_BAR; MM(1, 0, At, B0); MM(1, 1, At, B1); PG8_BAR; PG8_SCHED; \
            PG8_LDB(B0, 1, 0); PG8_LDB(B1, 1, 1); PG8_SCHED; PG8_LDA(At, 1, 0); PG8_STAGE(PG8_SA(0, 1), rA, a2 + hstepA, voffA); \
            PG8_WAIT_V(8); PG8_WAIT_L(0); PG8_BAR; MM(0, 0, At, B0); MM(0, 1, At, B1); PG8_BAR; PG8_SCHED; \
            PG8_LDA(At, 1, 1); PG8_STAGE(PG8_SB(1, 0), rB, b3, voffB); PG8_STAGE(PG8_SB(1, 1), rB, b3 + hstepB, voffB); PG8_STAGE(PG8_SA(1, 0), rA, a3, voffA); \
            PG8_WAIT_V(8); PG8_WAIT_L(0); PG8_BAR; MM(1, 0, At, B0); MM(1, 1, At, B1); PG8_BAR; PG8_SCHED; } while (0)
        if constexpr (MIXT > 0) {
            for (int t = 0; t < MIXT; t += 2) PG8_KSTEP(PG8_MMA_Q);
            E.mid(acc, cur, wr, wc, fr, fq);
            for (int t = MIXT; t < nt; t += 2) PG8_KSTEP(PG8_MMA);
        } else {
            for (int t = 0; t < nt; t += 2) {
                if constexpr (has_mid<Epi>::value > 0) { if (t == has_mid<Epi>::value) E.mid(acc, cur, wr, wc, fr, fq); }
                PG8_KSTEP(PG8_MMA);
            }
        }
#undef PG8_KSTEP
        if constexpr (ALIGN_EPI) { if (wr == 0) PG8_BAR; }
        E(acc, cur, wr, wc, fr, fq); S.done(cur);
        if (!has_next) break;
#pragma unroll
        for (int a = 0; a < 2; ++a)
#pragma unroll
            for (int b = 0; b < 2; ++b)
#pragma unroll
                for (int m = 0; m < 4; ++m)
#pragma unroll
                    for (int n = 0; n < 2; ++n) acc[a][b][m][n] = (acc_t)(0);
        cur = nxt; cA = nA; cB = nB; ++ui;
        if constexpr (ALIGN_EPI) { if (wr == 1) PG8_BAR; }
    }
    PG8_WAIT_V(0);
    if constexpr (!ALIGN_EPI) { if (wr == 0) PG8_BAR; }
    PG8_BAR;
#undef PG8_SA
#undef PG8_SB
#undef PG8_STAGE
#undef PG8_LDA
#undef PG8_LDB
#undef PG8_MMA
#undef PG8_MMA_Q
#undef PG8_WAIT_V
#undef PG8_WAIT_L
#undef PG8_BAR
#undef PG8_SCHED
}
}

#define GAS __attribute__((address_space(1)))
#define LAS __attribute__((address_space(3)))
typedef unsigned short bf16;
typedef unsigned v4u __attribute__((ext_vector_type(4)));
typedef float f32x4 __attribute__((ext_vector_type(4)));
typedef GAS unsigned gu32;
#define RLX_AGENT __ATOMIC_RELAXED, __HIP_MEMORY_SCOPE_AGENT
#define LDS_WAIT() asm volatile("s_waitcnt lgkmcnt(0)" ::: "memory")
#define VM_WAIT() asm volatile("s_waitcnt vmcnt(0)" ::: "memory")

namespace att {
using bf16x8 = __attribute__((ext_vector_type(8))) short;
using s16x4  = __attribute__((ext_vector_type(4))) short;
using f32x16 = __attribute__((ext_vector_type(16))) float;
using u32x4  = __attribute__((ext_vector_type(4))) unsigned;
constexpr int   D = 128, NW = 8, QBLK = 32, KVBLK = 64;
constexpr float SCALE = 0.088388347648318440f;
constexpr float THR = 8.f;
constexpr int SHM_V = KVBLK * D * 2, SHM_K = KVBLK * D * 2, SHM_ATTN = 2 * SHM_V + 2 * SHM_K + NW * 64 * 4;
#define KSWZ(row, colB) ((row) * 256 + ((colB) ^ (((row) & 15) << 4)))
#define SBAR() __builtin_amdgcn_sched_barrier(0)
__device__ __forceinline__ int crow(int r, int hi) { return (r & 3) + 8 * (r >> 2) + 4 * hi; }
__device__ __forceinline__ unsigned cvtpk(float lo, float hi) { unsigned r; asm volatile("v_cvt_pk_bf16_f32 %0, %1, %2" : "=v"(r) : "v"(lo), "v"(hi)); return r; }

__device__ __forceinline__ void partialSM(f32x16& p0, f32x16& p1, float& m_reg, float& mn, float& alpha) {
  constexpr float C = SCALE * 1.4426950408889634f;
  float pmax = p0[0];
#pragma unroll
  for (int r = 1; r < 16; ++r) pmax = fmaxf(pmax, p0[r]);
#pragma unroll
  for (int r = 0; r < 16; ++r) pmax = fmaxf(pmax, p1[r]);
  { auto rr = __builtin_amdgcn_permlane32_swap(__float_as_uint(pmax), __float_as_uint(pmax), false, false);
    pmax = fmaxf(__uint_as_float(rr[0]), __uint_as_float(rr[1])); }
  if (__builtin_expect(__all(pmax - m_reg <= THR / SCALE), 1)) { mn = m_reg; alpha = 1.f; }
  else { mn = fmaxf(m_reg, pmax); alpha = __builtin_amdgcn_exp2f((m_reg - mn) * C); m_reg = mn; }
  float mnC = -mn * C;
#pragma unroll
  for (int r = 0; r < 16; ++r) p0[r] = fmaf(p0[r], C, mnC);
#pragma unroll
  for (int r = 0; r < 16; ++r) p1[r] = fmaf(p1[r], C, mnC);
#pragma unroll
  for (int r = 0; r < 16; ++r) p0[r] = __builtin_amdgcn_exp2f(p0[r]);
}
__device__ __forceinline__ void finishSM(f32x16& p0, f32x16& p1, float alpha, float& l_reg, bf16x8& pa0, bf16x8& pa1, bf16x8& pa2, bf16x8& pa3) {
#pragma unroll
  for (int r = 0; r < 16; ++r) p1[r] = __builtin_amdgcn_exp2f(p1[r]);
  float ps = 0;
#pragma unroll
  for (int r = 0; r < 16; ++r) ps += p0[r];
#pragma unroll
  for (int r = 0; r < 16; ++r) ps += p1[r];
  { auto rr = __builtin_amdgcn_permlane32_swap(__float_as_uint(ps), __float_as_uint(ps), false, false);
    ps = __uint_as_float(rr[0]) + __uint_as_float(rr[1]); }
  l_reg = l_reg * alpha + ps;
#define PK4(P, BASE, OUT) do { unsigned a0 = cvtpk(P[BASE + 0], P[BASE + 1]), a1 = cvtpk(P[BASE + 2], P[BASE + 3]);   \
    unsigned b0 = cvtpk(P[BASE + 4], P[BASE + 5]), b1 = cvtpk(P[BASE + 6], P[BASE + 7]);                              \
    auto r0 = __builtin_amdgcn_permlane32_swap(a0, b0, false, false); auto r1 = __builtin_amdgcn_permlane32_swap(a1, b1, false, false); \
    u32x4 w = {r0[0], r1[0], r0[1], r1[1]}; OUT = *reinterpret_cast<bf16x8*>(&w); } while (0)
  PK4(p0, 0, pa0); PK4(p0, 8, pa1); PK4(p1, 0, pa2); PK4(p1, 8, pa3);
#undef PK4
}
__device__ __forceinline__ void qkt(f32x16& p0, f32x16& p1, const LAS char* Ks, const bf16x8* qr, int r32, int hi) {
  p0 = f32x16{}; p1 = f32x16{};
#pragma unroll
  for (int d0 = 0; d0 < 8; ++d0) { int cb = (d0 * 16 + hi * 8) * 2;
    bf16x8 b0 = *reinterpret_cast<const LAS bf16x8*>(Ks + KSWZ(r32, cb));
    bf16x8 b1 = *reinterpret_cast<const LAS bf16x8*>(Ks + KSWZ(32 + r32, cb));
    p0 = __builtin_amdgcn_mfma_f32_32x32x16_bf16(b0, qr[d0], p0, 0, 0, 0);
    p1 = __builtin_amdgcn_mfma_f32_32x32x16_bf16(b1, qr[d0], p1, 0, 0, 0); }
}
__device__ __forceinline__ int v_st(int k, int c) { const int kk = (k & ~0xC) | ((k & 4) << 1) | ((k & 8) >> 1); return ((kk >> 3) * 4 + (c >> 5)) * 512 + ((kk & 7) * 32 + (c & 31)) * 2; }
__device__ __forceinline__ int v_rd_base(int lane) { return ((lane & 3) << 3) | (((lane >> 2) & 3) << 6) | (((lane >> 4) & 1) << 5) | (((lane >> 5) & 1) << 8); }
constexpr int v_rd_off(int d0, int ks, int half) { return d0 * 512 + ks * 4096 + half * 2048; }
template <int OFF> __device__ __forceinline__ s16x4 tr_read(int vb) {
  s16x4 r; asm volatile("ds_read_b64_tr_b16 %0, %1 offset:%2" : "=&v"(r) : "v"(vb), "i"(OFF) : "memory"); return r;
}
template <int D0> __device__ __forceinline__ void pv_one(f32x16& od, int vb, bf16x8 pa0, bf16x8 pa1, bf16x8 pa2, bf16x8 pa3) {
  const s16x4 l0 = tr_read<v_rd_off(D0, 0, 0)>(vb), h0 = tr_read<v_rd_off(D0, 0, 1)>(vb), l1 = tr_read<v_rd_off(D0, 1, 0)>(vb), h1 = tr_read<v_rd_off(D0, 1, 1)>(vb);
  const s16x4 l2 = tr_read<v_rd_off(D0, 2, 0)>(vb), h2 = tr_read<v_rd_off(D0, 2, 1)>(vb), l3 = tr_read<v_rd_off(D0, 3, 0)>(vb), h3 = tr_read<v_rd_off(D0, 3, 1)>(vb);
  asm volatile("s_waitcnt lgkmcnt(0)" ::: "memory"); SBAR();
#define PK(L, H) (bf16x8){L[0], L[1], L[2], L[3], H[0], H[1], H[2], H[3]}
  od = __builtin_amdgcn_mfma_f32_32x32x16_bf16(pa0, PK(l0, h0), od, 0, 0, 0);
  od = __builtin_amdgcn_mfma_f32_32x32x16_bf16(pa1, PK(l1, h1), od, 0, 0, 0);
  od = __builtin_amdgcn_mfma_f32_32x32x16_bf16(pa2, PK(l2, h2), od, 0, 0, 0);
  od = __builtin_amdgcn_mfma_f32_32x32x16_bf16(pa3, PK(l3, h3), od, 0, 0, 0);
#undef PK
}
__device__ __forceinline__ void pv_d0(f32x16* o, int vb, bf16x8 pa0, bf16x8 pa1, bf16x8 pa2, bf16x8 pa3) {
  pv_one<0>(o[0], vb, pa0, pa1, pa2, pa3); pv_one<1>(o[1], vb, pa0, pa1, pa2, pa3); pv_one<2>(o[2], vb, pa0, pa1, pa2, pa3); pv_one<3>(o[3], vb, pa0, pa1, pa2, pa3);
}

template <bool WIN>
__device__ __forceinline__ void attn_unit(const bf16* __restrict__ Qb, int ldq, const bf16* __restrict__ Kh, const bf16* __restrict__ Vh, int ldk,
                                          bf16* __restrict__ Ob, int ldo, float* __restrict__ lse, int ldl,
                                          int NT, int kb0, int i0, int L, float slope_raw, LAS char* lds, const int wid  ) {
  int lane = lane_id(); asm volatile("" : "+v"(lane));
  const int tid = wid * 64 + lane, r32 = lane & 31, hi = lane >> 5;
  LAS char* V_lds = lds; LAS char* K_lds = lds + 2 * SHM_V;
  LAS float* ws = (LAS float*)(lds + 2 * SHM_V + 2 * SHM_K) + wid * 64; LAS float* li_l = ws; LAS float* al_l = ws + 32;
  float m_reg = -1e30f, l_reg = 0; f32x16 o[4] = {}; bf16x8 qr[8];
  { const unsigned qoff = (unsigned)((wid * QBLK + r32) * ldq + hi * 8) * 2u;
#pragma unroll
    for (int d0 = 0; d0 < 8; ++d0) qr[d0] = *reinterpret_cast<const bf16x8*>((const char*)Qb + qoff + d0 * 32); }
  const int sr = tid >> 4, sc = (tid & 15) * 8, vst0 = v_st(sr, sc), vst1 = v_st(32 + sr, sc);
  const int vb0 = (int)(uintptr_t)V_lds + v_rd_base(lane);
  const int qi = i0 + wid * QBLK + r32;
  const unsigned soff0 = (unsigned)(sr * ldk + sc) * 2u, soff1 = soff0 + (unsigned)(32 * ldk) * 2u;
  struct { bf16x8 vs0, vs1, ks0, ks1; } sr_[2];
#define KROW(t) (WIN ? min(max(kb0 + (t) * KVBLK, 0), L - KVBLK) : (t) * KVBLK)
#define SLOAD(i, k0) do { const size_t _ko = (size_t)(k0) * (size_t)ldk * 2; const char* _vb = (const char*)Vh + _ko; const char* _kb = (const char*)Kh + _ko; \
    sr_[i].vs0 = *reinterpret_cast<const bf16x8*>(_vb + soff0); sr_[i].vs1 = *reinterpret_cast<const bf16x8*>(_vb + soff1); \
    sr_[i].ks0 = *reinterpret_cast<const bf16x8*>(_kb + soff0); sr_[i].ks1 = *reinterpret_cast<const bf16x8*>(_kb + soff1); } while (0)
#define SWRITE(b, i) do { *(LAS bf16x8*)(V_lds + (b) * SHM_V + vst0) = sr_[i].vs0;          \
    *(LAS bf16x8*)(V_lds + (b) * SHM_V + vst1) = sr_[i].vs1; int kc = sc * 2;               \
    *(LAS bf16x8*)(K_lds + (b) * SHM_K + KSWZ(sr, kc)) = sr_[i].ks0;                       \
    *(LAS bf16x8*)(K_lds + (b) * SHM_K + KSWZ(32 + sr, kc)) = sr_[i].ks1; } while (0)
#define SWAIT() asm volatile("s_waitcnt vmcnt(4)" ::: "memory")
#define RESC(a) do { if (__any((a) < 1.f)) { if (hi == 0) al_l[r32] = (a); asm volatile("s_waitcnt lgkmcnt(0)" ::: "memory"); \
    _Pragma("unroll") for (int d = 0; d < 4; ++d) _Pragma("unroll") for (int r = 0; r < 16; ++r) o[d][r] *= al_l[crow(r, hi)]; } } while (0)
#define MASK(P0, P1, t) do { if constexpr (WIN) { const int kb = kb0 + (t) * KVBLK; const bool tok = (kb >= 0) && (kb < L); const float dlf = tok ? (float)(kb + 4 * hi - qi) : 1.0e9f; \
    _Pragma("unroll") for (int r = 0; r < 16; ++r) { const float d0 = dlf + (float)((r & 3) + 8 * (r >> 2)), d1 = d0 + 32.f; \
      P0[r] = (__builtin_fabsf(d0) <= 64.f) ? fmaf(-slope_raw, __builtin_fabsf(d0), P0[r]) : -__builtin_inff(); \
      P1[r] = (__builtin_fabsf(d1) <= 64.f) ? fmaf(-slope_raw, __builtin_fabsf(d1), P1[r]) : -__builtin_inff(); } } } while (0)
  f32x16 pA0, pA1, pB0, pB1; float mnA, mnB, alA, alB; bf16x8 pa0, pa1, pa2, pa3;
  constexpr int SE = 0, SO = 1;
  SLOAD(SE, KROW(0)); asm volatile("s_waitcnt vmcnt(0)" ::: "memory"); SWRITE(0, SE); __syncthreads();
  qkt(pA0, pA1, K_lds, qr, r32, hi); MASK(pA0, pA1, 0); partialSM(pA0, pA1, m_reg, mnA, alA);
  SLOAD(SO, KROW(1)); if (2 < NT) SLOAD(SE, KROW(2));
  SWAIT(); SWRITE(1, SO); __syncthreads();
  for (int j = 1; j + 1 < NT; j += 2) {
    SBAR(); qkt(pB0, pB1, K_lds + SHM_K, qr, r32, hi);
    finishSM(pA0, pA1, alA, l_reg, pa0, pa1, pa2, pa3); SBAR();
    SLOAD(SO, KROW(j + 2)); SBAR();
    pv_d0(o, vb0, pa0, pa1, pa2, pa3); MASK(pB0, pB1, j); partialSM(pB0, pB1, m_reg, mnB, alB);
    __syncthreads(); SWAIT(); SWRITE(0, SE);
    RESC(alB); __syncthreads();
    SBAR(); qkt(pA0, pA1, K_lds, qr, r32, hi);
    finishSM(pB0, pB1, alB, l_reg, pa0, pa1, pa2, pa3); SBAR();
    if (j + 3 < NT) SLOAD(SE, KROW(j + 3)); SBAR();
    pv_d0(o, vb0 + SHM_V, pa0, pa1, pa2, pa3); MASK(pA0, pA1, j + 1); partialSM(pA0, pA1, m_reg, mnA, alA);
    __syncthreads(); SWAIT(); SWRITE(1, SO);
    RESC(alA); __syncthreads();
  }
  SBAR(); qkt(pB0, pB1, K_lds + SHM_K, qr, r32, hi);
  finishSM(pA0, pA1, alA, l_reg, pa0, pa1, pa2, pa3); SBAR();
  pv_d0(o, vb0, pa0, pa1, pa2, pa3); MASK(pB0, pB1, NT - 1); partialSM(pB0, pB1, m_reg, mnB, alB);
  __syncthreads(); RESC(alB);
  finishSM(pB0, pB1, alB, l_reg, pa0, pa1, pa2, pa3); SBAR();
  pv_d0(o, vb0 + SHM_V, pa0, pa1, pa2, pa3);
  if (hi == 0) li_l[r32] = l_reg; asm volatile("s_waitcnt lgkmcnt(0)" ::: "memory");
  float rli[16];
#pragma unroll
  for (int r = 0; r < 16; ++r) rli[r] = __builtin_amdgcn_rcpf(li_l[crow(r, hi)]);
#pragma unroll
  for (int r = 0; r < 16; ++r) { const unsigned ooff = (unsigned)((wid * QBLK + crow(r, hi)) * ldo + r32) * 2u;
#pragma unroll
    for (int d0 = 0; d0 < 4; ++d0) *(bf16*)((char*)Ob + ooff + d0 * 64) = (bf16)(cvtpk(o[d0][r] * rli[r], 0.f) & 0xffffu); }
  if constexpr (WIN) { if (hi == 0) lse[(size_t)((wid * QBLK + r32) * ldl)] = SCALE * m_reg + __logf(l_reg); }
#undef KROW
#undef SLOAD
#undef SWRITE
#undef SWAIT
#undef RESC
#undef MASK
}
__device__ __forceinline__ void dense_unit(const bf16* __restrict__ Qb, const bf16* __restrict__ Kh, const bf16* __restrict__ Vh, bf16* __restrict__ Ob, int ldo, int NT, LAS char* lds, const int wid) {
  int lane = lane_id(); asm volatile("" : "+v"(lane));
  const int r32 = lane & 31, hi = lane >> 5;
  LAS char* V_lds = lds; LAS char* K_lds = lds + 2 * SHM_V;
  LAS float* ws = (LAS float*)(lds + 2 * SHM_V + 2 * SHM_K) + wid * 64; LAS float* li_l = ws; LAS float* al_l = ws + 32;
  const __amdgpu_buffer_rsrc_t rK = __builtin_amdgcn_make_buffer_rsrc((void*)Kh, 0, 0x7fffffff, 0x00020000), rV = __builtin_amdgcn_make_buffer_rsrc((void*)Vh, 0, 0x7fffffff, 0x00020000);
  unsigned koff[2], voff[2];
#pragma unroll
  for (int i = 0; i < 2; ++i) { const int pc = wid * 2 + i, row = 4 * pc + (lane >> 4); koff[i] = (unsigned)(row * 256 + (((lane & 15) ^ (row & 15)) << 4));
    const int o = pc * 1024 + lane * 16, sub = o >> 9, w_ = (o & 511) >> 1, kk = (sub >> 2) * 8 + (w_ >> 5), c = (sub & 3) * 32 + (w_ & 31), k = (kk & ~0xC) | ((kk & 4) << 1) | ((kk & 8) >> 1);
    voff[i] = (unsigned)(k * 256 + c * 2); }
#define KDMA(t, b) do { const unsigned so_ = (unsigned)(t) * (unsigned)(KVBLK * 256); _Pragma("unroll") for (int i_ = 0; i_ < 2; ++i_) \
    __builtin_amdgcn_raw_ptr_buffer_load_lds(rK, (LAS void*)(K_lds + (b) * SHM_K + wid * 2048 + i_ * 1024), 16, koff[i_], so_, 0, 0); } while (0)
#define VDMA(t, b) do { const unsigned so_ = (unsigned)(t) * (unsigned)(KVBLK * 256); _Pragma("unroll") for (int i_ = 0; i_ < 2; ++i_) \
    __builtin_amdgcn_raw_ptr_buffer_load_lds(rV, (LAS void*)(V_lds + (b) * SHM_V + wid * 2048 + i_ * 1024), 16, voff[i_], so_, 0, 0); } while (0)
#define SYNCPT() do { asm volatile("s_waitcnt vmcnt(0) lgkmcnt(0)" ::: "memory"); __builtin_amdgcn_s_barrier(); asm volatile("" ::: "memory"); } while (0)
#define RESC(a) do { if (__any((a) < 1.f)) { if (hi == 0) al_l[r32] = (a); asm volatile("s_waitcnt lgkmcnt(0)" ::: "memory"); \
    _Pragma("unroll") for (int d = 0; d < 4; ++d) _Pragma("unroll") for (int r = 0; r < 16; ++r) o[d][r] *= al_l[crow(r, hi)]; } } while (0)
  SYNCPT();
  KDMA(0, 0); VDMA(0, 0); KDMA(1, 1);
  float m_reg = -1e30f, l_reg = 0; f32x16 o[4] = {}; bf16x8 qr[8];
  { const unsigned qoff = (unsigned)((wid * QBLK + r32) * D + hi * 8) * 2u;
#pragma unroll
    for (int d0 = 0; d0 < 8; ++d0) qr[d0] = *reinterpret_cast<const bf16x8*>((const char*)Qb + qoff + d0 * 32); }
  const int vb0 = (int)(uintptr_t)V_lds + v_rd_base(lane);
  f32x16 pA0, pA1, pB0, pB1; float mnA, mnB, alA, alB; bf16x8 pa0, pa1, pa2, pa3;
  SYNCPT();
  qkt(pA0, pA1, K_lds, qr, r32, hi); partialSM(pA0, pA1, m_reg, mnA, alA);
  SYNCPT(); KDMA(2, 0); VDMA(1, 1);
  for (int j = 1; j + 1 < NT; j += 2) {
    SBAR(); qkt(pB0, pB1, K_lds + SHM_K, qr, r32, hi);
    finishSM(pA0, pA1, alA, l_reg, pa0, pa1, pa2, pa3); SBAR();
    pv_d0(o, vb0, pa0, pa1, pa2, pa3); partialSM(pB0, pB1, m_reg, mnB, alB);
    SYNCPT(); KDMA(j + 2, 1); VDMA(j + 1, 0);
    RESC(alB);
    SBAR(); qkt(pA0, pA1, K_lds, qr, r32, hi);
    finishSM(pB0, pB1, alB, l_reg, pa0, pa1, pa2, pa3); SBAR();
    pv_d0(o, vb0 + SHM_V, pa0, pa1, pa2, pa3); partialSM(pA0, pA1, m_reg, mnA, alA);
    SYNCPT(); if (j + 3 < NT) KDMA(j + 3, 0); VDMA(j + 2, 1);
    RESC(alA);
  }
  SBAR(); qkt(pB0, pB1, K_lds + SHM_K, qr, r32, hi);
  finishSM(pA0, pA1, alA, l_reg, pa0, pa1, pa2, pa3); SBAR();
  pv_d0(o, vb0, pa0, pa1, pa2, pa3); partialSM(pB0, pB1, m_reg, mnB, alB);
  SYNCPT(); RESC(alB);
  finishSM(pB0, pB1, alB, l_reg, pa0, pa1, pa2, pa3); SBAR();
  pv_d0(o, vb0 + SHM_V, pa0, pa1, pa2, pa3);
  if (hi == 0) li_l[r32] = l_reg; asm volatile("s_waitcnt lgkmcnt(0)" ::: "memory");
  float rli[16];
#pragma unroll
  for (int r = 0; r < 16; ++r) rli[r] = __builtin_amdgcn_rcpf(li_l[crow(r, hi)]);
#pragma unroll
  for (int r = 0; r < 16; ++r) { const unsigned ooff = (unsigned)((wid * QBLK + crow(r, hi)) * ldo + r32) * 2u;
#pragma unroll
    for (int d0 = 0; d0 < 4; ++d0) *(bf16*)((char*)Ob + ooff + d0 * 64) = (bf16)(cvtpk(o[d0][r] * rli[r], 0.f) & 0xffffu); }
#undef KDMA
#undef VDMA
#undef SYNCPT
#undef RESC
}
__device__ __forceinline__ void win_unit(const bf16* __restrict__ Qp, const bf16* __restrict__ Kp, const bf16* __restrict__ Vp, bf16* __restrict__ Op, int ldo, float* __restrict__ lsep, int ldl,
                                         int i0, int L, float slope_raw, LAS char* lds, const int wid) {
  int lane = lane_id(); asm volatile("" : "+v"(lane));
  const int r32 = lane & 31, hi = lane >> 5, kstart = i0 - 64;
  constexpr float C = SCALE * 1.4426950408889634f;
  LAS float* li_l = (LAS float*)(lds + 98304 + wid * 256);
  const __amdgpu_buffer_rsrc_t rK = __builtin_amdgcn_make_buffer_rsrc((void*)Kp, 0, 0x7fffffff, 0x00020000), rV = __builtin_amdgcn_make_buffer_rsrc((void*)Vp, 0, 0x7fffffff, 0x00020000);
  __syncthreads();
#pragma unroll
  for (int j = 0; j < 12; ++j) { const int pc = wid * 12 + j, row = 4 * pc + (lane >> 4), chunk = (lane & 15) ^ (row & 15);
    const int grow = min(max(kstart + row, 0), L - 1);
    __builtin_amdgcn_raw_ptr_buffer_load_lds(rK, (LAS void*)(lds + pc * 1024), 16, (unsigned)(grow * 256 + chunk * 16), 0, 0, 0); }
  bf16x8 qr[8];
  { const bf16* q = Qp + (size_t)(wid * 32 + r32) * D + hi * 8;
#pragma unroll
    for (int d0 = 0; d0 < 8; ++d0) qr[d0] = *reinterpret_cast<const bf16x8*>(q + d0 * 16); }
  asm volatile("s_waitcnt vmcnt(0)" ::: "memory"); __syncthreads();
  f32x16 p[5];
#pragma unroll
  for (int s = 0; s < 5; ++s) {
    const int rb = 32 * wid + 32 * s;
    const bool tok = (kstart + rb >= 0) && (kstart + rb < L);
    f32x16 acc = {};
#pragma unroll
    for (int d0 = 0; d0 < 8; ++d0) { const int cb = (d0 * 16 + hi * 8) * 2;
      const bf16x8 kf = *reinterpret_cast<const LAS bf16x8*>(lds + rb * 256 + KSWZ(r32, cb));
      acc = __builtin_amdgcn_mfma_f32_32x32x16_bf16(kf, qr[d0], acc, 0, 0, 0); }
    const float dlf = tok ? (float)(32 * s - 64 + 4 * hi - r32) : 1.0e9f;
#pragma unroll
    for (int r = 0; r < 16; ++r) { const float dd = dlf + (float)((r & 3) + 8 * (r >> 2));
      acc[r] = (__builtin_fabsf(dd) <= 64.f) ? fmaf(-slope_raw, __builtin_fabsf(dd), acc[r]) : -__builtin_inff(); }
    p[s] = acc;
  }
  asm volatile("s_waitcnt lgkmcnt(0)" ::: "memory"); __syncthreads();
#pragma unroll
  for (int j = 0; j < 12; ++j) { const int pc = wid * 12 + j, img = pc >> 4, o = (pc & 15) * 1024 + lane * 16;
    const int sub = o >> 9, w_ = (o & 511) >> 1, kk = (sub >> 2) * 8 + (w_ >> 5), c = (sub & 3) * 32 + (w_ & 31), k = (kk & ~0xC) | ((kk & 4) << 1) | ((kk & 8) >> 1);
    const int grow = min(max(kstart + img * 64 + k, 0), L - 1);
    __builtin_amdgcn_raw_ptr_buffer_load_lds(rV, (LAS void*)(lds + pc * 1024), 16, (unsigned)(grow * 256 + c * 2), 0, 0, 0); }
  float m = p[0][0];
#pragma unroll
  for (int s = 0; s < 5; ++s)
#pragma unroll
    for (int r = 0; r < 16; ++r) m = fmaxf(m, p[s][r]);
  { auto rr = __builtin_amdgcn_permlane32_swap(__float_as_uint(m), __float_as_uint(m), false, false); m = fmaxf(__uint_as_float(rr[0]), __uint_as_float(rr[1])); }
  const float mC = -m * C; float l = 0.f;
#pragma unroll
  for (int s = 0; s < 5; ++s)
#pragma unroll
    for (int r = 0; r < 16; ++r) { const float e = __builtin_amdgcn_exp2f(fmaf(p[s][r], C, mC)); p[s][r] = e; l += e; }
  { auto rr = __builtin_amdgcn_permlane32_swap(__float_as_uint(l), __float_as_uint(l), false, false); l = __uint_as_float(rr[0]) + __uint_as_float(rr[1]); }
  bf16x8 pa[5][2];
#define WPK4(P, BASE, OUT) do { unsigned a0 = cvtpk(P[BASE + 0], P[BASE + 1]), a1 = cvtpk(P[BASE + 2], P[BASE + 3]);   \
    unsigned b0 = cvtpk(P[BASE + 4], P[BASE + 5]), b1 = cvtpk(P[BASE + 6], P[BASE + 7]);                              \
    auto r0 = __builtin_amdgcn_permlane32_swap(a0, b0, false, false); auto r1 = __builtin_amdgcn_permlane32_swap(a1, b1, false, false); \
    u32x4 w = {r0[0], r1[0], r0[1], r1[1]}; OUT = *reinterpret_cast<bf16x8*>(&w); } while (0)
#pragma unroll
  for (int s = 0; s < 5; ++s) { WPK4(p[s], 0, pa[s][0]); WPK4(p[s], 8, pa[s][1]); }
#undef WPK4
  asm volatile("s_waitcnt vmcnt(0)" ::: "memory"); __syncthreads();
  f32x16 o[4] = {};
  const int vb0 = (int)(uintptr_t)lds + v_rd_base(lane);
#pragma unroll
  for (int s = 0; s < 5; ++s) {
    const int ko = 32 * wid + 32 * s;
    const int vb = vb0 + (ko >> 6) * 16384 + ((ko >> 5) & 1) * 8192;
#define WPV(D0) do { const s16x4 l0 = tr_read<v_rd_off(D0, 0, 0)>(vb), h0 = tr_read<v_rd_off(D0, 0, 1)>(vb), l1 = tr_read<v_rd_off(D0, 1, 0)>(vb), h1 = tr_read<v_rd_off(D0, 1, 1)>(vb); \
      asm volatile("s_waitcnt lgkmcnt(0)" ::: "memory"); SBAR(); \
      o[D0] = __builtin_amdgcn_mfma_f32_32x32x16_bf16(pa[s][0], (bf16x8){l0[0], l0[1], l0[2], l0[3], h0[0], h0[1], h0[2], h0[3]}, o[D0], 0, 0, 0); \
      o[D0] = __builtin_amdgcn_mfma_f32_32x32x16_bf16(pa[s][1], (bf16x8){l1[0], l1[1], l1[2], l1[3], h1[0], h1[1], h1[2], h1[3]}, o[D0], 0, 0, 0); } while (0)
    WPV(0); WPV(1); WPV(2); WPV(3);
#undef WPV
  }
  if (hi == 0) li_l[r32] = l; asm volatile("s_waitcnt lgkmcnt(0)" ::: "memory");
  float rli[16];
#pragma unroll
  for (int r = 0; r < 16; ++r) rli[r] = __builtin_amdgcn_rcpf(li_l[crow(r, hi)]);
#pragma unroll
  for (int r = 0; r < 16; ++r) { const unsigned ooff = (unsigned)((wid * 32 + crow(r, hi)) * ldo + r32) * 2u;
#pragma unroll
    for (int d0 = 0; d0 < 4; ++d0) *(bf16*)((char*)Op + ooff + d0 * 64) = (bf16)(cvtpk(o[d0][r] * rli[r], 0.f) & 0xffffu); }
  if (hi == 0) lsep[(size_t)((wid * 32 + r32) * ldl)] = SCALE * m + __logf(l);
}
}

constexpr int NWAVES = 8;
constexpr int BATCH = 4, T = 4096, DM = 4096, M = BATCH * T, FF = 11008, HD = 128;
constexpr int INW = 20480, C_QA = 0, C_KA = 2048, C_VA = 2560, C_QKVB = 3072, C_GA = 12288, C_GB = 16384;
constexpr int GW = 8192;
constexpr int S_QA = 0, S_KA = 16, S_VA = 20, S_B = 24, N_SLOTS = 96;
constexpr int YW = 3072;
constexpr float RMS_EPS = 1e-6f;
constexpr int N_PHASES = 12;
constexpr int KQ1 = 3072, ROWB1 = KQ1 + (DM - KQ1) * 2;

constexpr size_t MiB = 1u << 20;
constexpr size_t WS_CTL = 0, CTL_ZERO_BYTES = 1 * MiB;
constexpr size_t WS_WGU = 2 * MiB;
constexpr size_t WS_WDN = 174 * MiB;
constexpr size_t WS_WIN = 260 * MiB;
constexpr size_t WS_WBR = 420 * MiB;
constexpr size_t WS_WOUT = 444 * MiB;
constexpr size_t WS_XN = 476 * MiB;
constexpr size_t WS_BIG = 604 * MiB;
constexpr size_t WS_Y = 1244 * MiB;
constexpr size_t WS_OG = 1340 * MiB;
constexpr size_t WS_LSE = 1436 * MiB;
constexpr size_t WS_XN2 = 1438 * MiB;
constexpr size_t WS_END = 1566 * MiB;
constexpr int CW_BAR = 4096;
constexpr int CW_SS1 = 65536, CW_SS2 = 65536 + 16384;
static_assert((CW_SS2 + 16384) * 4 <= (int)CTL_ZERO_BYTES, "ctl map");

constexpr int RING_OFF = 0, RING_BYTES = 131072;
constexpr int LDSCTL_OFF = RING_BYTES, MISC_OFF = LDSCTL_OFF + 320;
constexpr int LDS_BYTES = 147456;
static_assert(att::SHM_ATTN <= RING_BYTES, "attention LDS inside the ring region");

#define XB_TMO      128
#define XB_XCNT(j)  (256  + 64 * (j))
#define XB_XSUB(j)  (1280 + 64 * (j))
#define XB_XGEN(j)  (2304 + 64 * (j))
#define XB_TOP      3328
#define XB_TOPGEN   3392
#define XCD_BAR_WORDS 3456
#define XB_SPIN_CAP (1u << 18)

__device__ __forceinline__ unsigned xb_ld(unsigned* p)              { return __hip_atomic_load(p, __ATOMIC_RELAXED, __HIP_MEMORY_SCOPE_AGENT); }
__device__ __forceinline__ unsigned xb_add(unsigned* p, unsigned v) { return __hip_atomic_fetch_add(p, v, __ATOMIC_RELAXED, __HIP_MEMORY_SCOPE_AGENT); }
__device__ __forceinline__ unsigned xb_xcc_id() { return (unsigned)__builtin_amdgcn_s_getreg((3 << 11) | 20) & 0xFu; }
#define XB_SPIN(cond, bar) do { unsigned _sp = 0; while (cond) { __builtin_amdgcn_s_sleep(1); \
    if ((++_sp & 255u) == 0u) { if (xb_ld(&(bar)[XB_TMO])) break; if (_sp > XB_SPIN_CAP) { atomicAdd(&(bar)[XB_TMO], 1u); break; } } } } while (0)

struct XcdBarrier { unsigned* bar; unsigned x; volatile LAS unsigned* st; };

__device__ __forceinline__ XcdBarrier xcd_barrier_post(unsigned* bar, volatile LAS unsigned* st) {
    XcdBarrier b; b.bar = bar; b.x = xb_xcc_id(); b.st = st;
    if (threadIdx.x == 0) (void)xb_add(&bar[XB_XCNT(b.x)], 1u);
    return b;
}
__device__ __forceinline__ void xcd_barrier_complete(unsigned* bar, unsigned x, unsigned& nloc, unsigned& nx) {
    const unsigned G = gridDim.x * gridDim.y * gridDim.z;
    unsigned sum, cnt, mine, sp = 0u;
    for (;;) {
        sum = 0u; cnt = 0u; mine = 0u;
#pragma unroll
        for (unsigned j = 0; j < 16; ++j) { const unsigned c = xb_ld(&bar[XB_XCNT(j)]); sum += c; cnt += (c > 0u) ? 1u : 0u; mine = (j == x) ? c : mine; }
        if (sum == G) break;
        __builtin_amdgcn_s_sleep(1);
        if ((++sp & 255u) == 0u) { if (xb_ld(&bar[XB_TMO])) break; if (sp > XB_SPIN_CAP) { atomicAdd(&bar[XB_TMO], 1u); break; } }
    }
    nloc = mine > 0u ? mine : 1u; nx = cnt > 0u ? cnt : 1u;
}
__device__ __forceinline__ void xcd_barrier(const XcdBarrier& b) {
    asm volatile("s_waitcnt vmcnt(0)" ::: "memory");
    __syncthreads();
    if (threadIdx.x == 0) {
        unsigned* bar = b.bar;
        __builtin_amdgcn_s_waitcnt(0);
        unsigned nloc = b.st[0], nx = b.st[1];
        if (nloc == 0u) { xcd_barrier_complete(bar, b.x, nloc, nx); b.st[0] = nloc; b.st[1] = nx; }
        const unsigned old = xb_add(&bar[XB_XSUB(b.x)], 1u);
        const unsigned gen = old / nloc;
        if (old + 1u == (gen + 1u) * nloc) {
            __builtin_amdgcn_fence(__ATOMIC_RELEASE, "agent");
            asm volatile("s_waitcnt vmcnt(0)" ::: "memory");
            const unsigned og = xb_add(&bar[XB_TOP], 1u);
            const unsigned tg = og / nx;
            if (og + 1u == (tg + 1u) * nx) xb_add(&bar[XB_TOPGEN], 1u);
            else XB_SPIN(xb_ld(&bar[XB_TOPGEN]) == tg, bar);
            __builtin_amdgcn_fence(__ATOMIC_ACQUIRE, "agent");
            xb_add(&bar[XB_XGEN(b.x)], 1u);
            asm volatile("s_waitcnt vmcnt(0)" ::: "memory");
        } else {
            XB_SPIN(xb_ld(&bar[XB_XGEN(b.x)]) == gen, bar);
            __builtin_amdgcn_fence(__ATOMIC_ACQUIRE, "agent");
            asm volatile("s_waitcnt vmcnt(0)" ::: "memory");
        }
    }
    __syncthreads();
}

__device__ __forceinline__ unsigned f2bf(float f) { unsigned u = __builtin_bit_cast(unsigned, f); return (u + 0x7fffu + ((u >> 16) & 1u)) >> 16; }
__device__ __forceinline__ unsigned pk2(float lo, float hi) { return f2bf(lo) | (f2bf(hi) << 16); }
__device__ __forceinline__ float wave_sum(float v) {
#pragma unroll
    for (int o = 1; o < 64; o <<= 1) v += __shfl_xor(v, o);
    return v;
}
__device__ __forceinline__ void transpose_item(const float* __restrict__ W, int N, bf16* __restrict__ WT, size_t ldt, int k0, int n0, int drow0, int dcol0, LAS float* scr, int lane, const float* __restrict__ kgain = nullptr  ) {
    f32x4 v[8];
#pragma unroll
    for (int i = 0; i < 8; ++i) v[i] = *(const GAS f32x4*)(W + (size_t)(k0 + 8 * i + (lane >> 3)) * N + n0 + 4 * (lane & 7));
#pragma unroll
    for (int i = 0; i < 8; ++i) { LAS float* d = scr + (8 * i + (lane >> 3)) * 33 + 4 * (lane & 7); const float gk = kgain ? kgain[k0 + 8 * i + (lane >> 3)] : 1.0f; d[0] = v[i].x * gk; d[1] = v[i].y * gk; d[2] = v[i].z * gk; d[3] = v[i].w * gk; }
    LDS_WAIT(); asm volatile("" ::: "memory");
    const int c = lane & 7;
#pragma unroll
    for (int j = 0; j < 4; ++j) { const int n = (lane >> 3) + 8 * j; const LAS float* s = scr + (8 * c) * 33 + n;
        v4u o; o.x = pk2(s[0 * 33], s[1 * 33]); o.y = pk2(s[2 * 33], s[3 * 33]); o.z = pk2(s[4 * 33], s[5 * 33]); o.w = pk2(s[6 * 33], s[7 * 33]);
        *(GAS v4u*)(WT + (size_t)(drow0 + n) * ldt + dcol0 + 8 * c) = o; }
    LDS_WAIT(); asm volatile("" ::: "memory");
}
__device__ __forceinline__ void tr_plain(const float* W, int N, bf16* WT, size_t ldt, int dcol0, int item, LAS float* scr, int lane, const float* kgain = nullptr) {
    const int nblk = N / 32, kb = item / nblk, nb = item % nblk;
    transpose_item(W, N, WT, ldt, 64 * kb, 32 * nb, 32 * nb, dcol0 + 64 * kb, scr, lane, kgain);
}
__device__ __forceinline__ void tr_blocked(const float* W, int N, bf16* WT, int item, LAS float* scr, int lane) {
    const int nblk = N / 32, kb = item / nblk, nb = item % nblk;
    transpose_item(W, N, WT + (size_t)(kb >> 1) * N * 128, 128, 64 * kb, 32 * nb, 32 * nb, (kb & 1) * 64, scr, lane);
}
__device__ __forceinline__ void tr_gu(const float* W, int sel, bf16* WT, int item, LAS float* scr, int lane, const float* kgain = nullptr) {
    constexpr int nblk = FF / 32; const int kb = item / nblk, nb = item % nblk, n0 = 32 * nb;
    transpose_item(W, FF, WT, DM, 64 * kb, n0, (n0 >> 7) * 256 + sel * 128 + (n0 & 127), 64 * kb, scr, lane, kgain);
}
constexpr int IT_GU = (DM / 64) * (FF / 32), IT_DN = (FF / 64) * (DM / 32), IT_IN = (DM / 64) * (INW / 32), IT_BA = (2048 / 64) * (DM / 32), IT_BB = (1024 / 64) * (DM / 32), IT_OUT = (DM / 64) * (DM / 32);

constexpr int IT_D1 = IT_IN + IT_OUT + IT_BA + IT_BB + IT_DN;
#ifndef TAIL9_ITEMS
#define TAIL9_ITEMS 22016
#endif
#ifndef TAIL1_ITEMS
#define TAIL1_ITEMS 24576
#endif
__device__ __forceinline__ void conv_deferred(int r, const float* const* in, bf16* WIN_t, bf16* WOUT, bf16* WBR, bf16* WDN, LAS float* scr, int lane) {
    if (r < IT_IN) { tr_plain(in[6], INW, WIN_t, DM, 0, r, scr, lane, in[5]  ); return; } r -= IT_IN;
    if (r < IT_OUT) { tr_plain(in[11], DM, WOUT, DM, 0, r, scr, lane); return; } r -= IT_OUT;
    if (r < IT_BA) { tr_plain(in[9], DM, WBR, YW, 0, r, scr, lane); return; } r -= IT_BA;
    if (r < IT_BB) { tr_plain(in[10], DM, WBR, YW, 2048, r, scr, lane); return; } r -= IT_BB;
    tr_blocked(in[4], DM, WDN, r, scr, lane);
}
#define TAIL_WORK(nwg_, nitems_, CALL) do { const int full_ = (nwg_) / G, extra_ = (nwg_) - full_ * G; const bool grp_ = (extra_ > 0 && extra_ < G); \
    const int nconv_ = grp_ ? (G - extra_) : G, myc_ = grp_ ? (bx - extra_) : bx; \
    if (myc_ >= 0) for (int it = myc_ * NWAVES + wave; it < (nitems_); it += nconv_ * NWAVES) { CALL; } } while (0)

__device__ __forceinline__ void rms_row_to_bf16(const float* __restrict__ xrow, const float* __restrict__ g, bf16* __restrict__ orow, int lane) {
    const GAS f32x4* xr = (const GAS f32x4*)xrow + lane;
    f32x4 v[16]; float s = 0.f;
#pragma unroll
    for (int j = 0; j < 16; ++j) { v[j] = xr[64 * j]; s += (v[j].x * v[j].x + v[j].y * v[j].y) + (v[j].z * v[j].z + v[j].w * v[j].w); }
    const float rstd = 1.0f / sqrtf(wave_sum(s) * (1.f / DM) + RMS_EPS);
    const GAS f32x4* gr = (const GAS f32x4*)g + lane;
    GAS unsigned long long* o8 = (GAS unsigned long long*)orow + lane;
#pragma unroll
    for (int j = 0; j < 16; ++j) { const f32x4 gg = gr[64 * j];
        o8[64 * j] = (unsigned long long)pk2(v[j].x * rstd * gg.x, v[j].y * rstd * gg.y) | ((unsigned long long)pk2(v[j].z * rstd * gg.z, v[j].w * rstd * gg.w) << 32); }
}
__device__ __forceinline__ void rms_row_to_f32(const float* __restrict__ xrow, const float* __restrict__ g, float* __restrict__ orow, int lane) {
    const GAS f32x4* xr = (const GAS f32x4*)xrow + lane;
    f32x4 v[16]; float s = 0.f;
#pragma unroll
    for (int j = 0; j < 16; ++j) { v[j] = xr[64 * j]; s += (v[j].x * v[j].x + v[j].y * v[j].y) + (v[j].z * v[j].z + v[j].w * v[j].w); }
    const float rstd = 1.0f / sqrtf(wave_sum(s) * (1.f / DM) + RMS_EPS);
    const GAS f32x4* gr = (const GAS f32x4*)g + lane;
    GAS f32x4* o = (GAS f32x4*)orow + lane;
#pragma unroll
    for (int j = 0; j < 16; ++j) { const f32x4 gg = gr[64 * j]; o[64 * j] = (f32x4){v[j].x * rstd * gg.x, v[j].y * rstd * gg.y, v[j].z * rstd * gg.z, v[j].w * rstd * gg.w}; }
}
template <bool OUT_BF16>
__device__ __forceinline__ void rms_row2(const float* __restrict__ xa, const float* __restrict__ xb, const float* __restrict__ g, void* __restrict__ oa, void* __restrict__ ob, int lane) {
    const GAS f32x4* ra = (const GAS f32x4*)xa + lane; const GAS f32x4* rb = (const GAS f32x4*)xb + lane;
    f32x4 va[16], vb[16]; float sa = 0.f, sb = 0.f;
#pragma unroll
    for (int j = 0; j < 16; ++j) va[j] = ra[64 * j];
#pragma unroll
    for (int j = 0; j < 16; ++j) vb[j] = rb[64 * j];
#pragma unroll
    for (int j = 0; j < 16; ++j) sa += (va[j].x * va[j].x + va[j].y * va[j].y) + (va[j].z * va[j].z + va[j].w * va[j].w);
#pragma unroll
    for (int j = 0; j < 16; ++j) sb += (vb[j].x * vb[j].x + vb[j].y * vb[j].y) + (vb[j].z * vb[j].z + vb[j].w * vb[j].w);
    const float rsa = 1.0f / sqrtf(wave_sum(sa) * (1.f / DM) + RMS_EPS), rsb = 1.0f / sqrtf(wave_sum(sb) * (1.f / DM) + RMS_EPS);
    const GAS f32x4* gr = (const GAS f32x4*)g + lane;
#pragma unroll
    for (int j = 0; j < 16; ++j) { const f32x4 gg = gr[64 * j];
        const f32x4 ya = {va[j].x * rsa * gg.x, va[j].y * rsa * gg.y, va[j].z * rsa * gg.z, va[j].w * rsa * gg.w}, yb = {vb[j].x * rsb * gg.x, vb[j].y * rsb * gg.y, vb[j].z * rsb * gg.z, vb[j].w * rsb * gg.w};
        if constexpr (OUT_BF16) { ((GAS unsigned long long*)oa + lane)[64 * j] = (unsigned long long)pk2(ya.x, ya.y) | ((unsigned long long)pk2(ya.z, ya.w) << 32);
                                  ((GAS unsigned long long*)ob + lane)[64 * j] = (unsigned long long)pk2(yb.x, yb.y) | ((unsigned long long)pk2(yb.z, yb.w) << 32); }
        else { ((GAS f32x4*)oa + lane)[64 * j] = ya; ((GAS f32x4*)ob + lane)[64 * j] = yb; } }
}
__device__ __forceinline__ unsigned q4_pack(float a, float b, float c, float d, float inv) {
    const int ia = (int)__builtin_rintf(a * inv), ib = (int)__builtin_rintf(b * inv), ic = (int)__builtin_rintf(c * inv), id = (int)__builtin_rintf(d * inv);
    return (unsigned)(ia & 0xff) | ((unsigned)(ib & 0xff) << 8) | ((unsigned)(ic & 0xff) << 16) | ((unsigned)(id & 0xff) << 24);
}
template <int NCH = 8  >
__device__ __forceinline__ void quant_row2(const bf16* __restrict__ xa, const bf16* __restrict__ xb, unsigned char* __restrict__ qa, unsigned char* __restrict__ qb, float* sa, float* sb, float mula, float mulb, int lane) {
    const GAS v4u* ra = (const GAS v4u*)xa + lane; const GAS v4u* rb = (const GAS v4u*)xb + lane;
    v4u va[NCH], vb[NCH];
#pragma unroll
    for (int j = 0; j < NCH; ++j) va[j] = ra[64 * j];
#pragma unroll
    for (int j = 0; j < NCH; ++j) vb[j] = rb[64 * j];
    float ma = 0.f, mb = 0.f;
#pragma unroll
    for (int j = 0; j < NCH; ++j) {
#pragma unroll
        for (int c = 0; c < 4; ++c) { ma = fmaxf(ma, fmaxf(__builtin_fabsf(pg8::bf_lo(va[j][c])), __builtin_fabsf(pg8::bf_hi(va[j][c])))); mb = fmaxf(mb, fmaxf(__builtin_fabsf(pg8::bf_lo(vb[j][c])), __builtin_fabsf(pg8::bf_hi(vb[j][c])))); } }
#pragma unroll
    for (int o = 1; o < 64; o <<= 1) { ma = fmaxf(ma, __shfl_xor(ma, o)); mb = fmaxf(mb, __shfl_xor(mb, o)); }
    const float sca = ma > 0.f ? ma * (1.0f / 127.0f) : 1.0f, scb = mb > 0.f ? mb * (1.0f / 127.0f) : 1.0f, ia = 1.0f / sca, ib = 1.0f / scb;
    if (lane == 0) { *sa = sca * mula; *sb = scb * mulb; }
#pragma unroll
    for (int j = 0; j < NCH; ++j) {
        const unsigned long long pa = (unsigned long long)q4_pack(pg8::bf_lo(va[j].x), pg8::bf_hi(va[j].x), pg8::bf_lo(va[j].y), pg8::bf_hi(va[j].y), ia) | ((unsigned long long)q4_pack(pg8::bf_lo(va[j].z), pg8::bf_hi(va[j].z), pg8::bf_lo(va[j].w), pg8::bf_hi(va[j].w), ia) << 32);
        const unsigned long long pb = (unsigned long long)q4_pack(pg8::bf_lo(vb[j].x), pg8::bf_hi(vb[j].x), pg8::bf_lo(vb[j].y), pg8::bf_hi(vb[j].y), ib) | ((unsigned long long)q4_pack(pg8::bf_lo(vb[j].z), pg8::bf_hi(vb[j].z), pg8::bf_lo(vb[j].w), pg8::bf_hi(vb[j].w), ib) << 32);
        ((GAS unsigned long long*)qa + lane)[64 * j] = pa; ((GAS unsigned long long*)qb + lane)[64 * j] = pb; }
}
template <int KQ>
__device__ __forceinline__ void rms_row_mixed2(const float* __restrict__ xa, const float* __restrict__ xb, const float* __restrict__ g, unsigned char* __restrict__ oa, unsigned char* __restrict__ ob, float* sa, float* sb, int lane) {
    constexpr int JQ = KQ / 256;
    const GAS f32x4* ra = (const GAS f32x4*)xa + lane; const GAS f32x4* rb = (const GAS f32x4*)xb + lane;
    f32x4 va[16], vb[16]; float s2a = 0.f, s2b = 0.f;
#pragma unroll
    for (int j = 0; j < 16; ++j) va[j] = ra[64 * j];
#pragma unroll
    for (int j = 0; j < 16; ++j) vb[j] = rb[64 * j];
#pragma unroll
    for (int j = 0; j < 16; ++j) s2a += (va[j].x * va[j].x + va[j].y * va[j].y) + (va[j].z * va[j].z + va[j].w * va[j].w);
#pragma unroll
    for (int j = 0; j < 16; ++j) s2b += (vb[j].x * vb[j].x + vb[j].y * vb[j].y) + (vb[j].z * vb[j].z + vb[j].w * vb[j].w);
    const float rsa = 1.0f / sqrtf(wave_sum(s2a) * (1.f / DM) + RMS_EPS), rsb = 1.0f / sqrtf(wave_sum(s2b) * (1.f / DM) + RMS_EPS);
    const GAS f32x4* gr = (const GAS f32x4*)g + lane;
    float ma = 0.f, mb = 0.f;
#pragma unroll
    for (int j = 0; j < 16; ++j) { const f32x4 gg = gr[64 * j];
        va[j] = (f32x4){va[j].x * rsa * gg.x, va[j].y * rsa * gg.y, va[j].z * rsa * gg.z, va[j].w * rsa * gg.w}; vb[j] = (f32x4){vb[j].x * rsb * gg.x, vb[j].y * rsb * gg.y, vb[j].z * rsb * gg.z, vb[j].w * rsb * gg.w};
        if (j < JQ) { ma = fmaxf(ma, fmaxf(fmaxf(__builtin_fabsf(va[j].x), __builtin_fabsf(va[j].y)), fmaxf(__builtin_fabsf(va[j].z), __builtin_fabsf(va[j].w))));
                      mb = fmaxf(mb, fmaxf(fmaxf(__builtin_fabsf(vb[j].x), __builtin_fabsf(vb[j].y)), fmaxf(__builtin_fabsf(vb[j].z), __builtin_fabsf(vb[j].w)))); } }
#pragma unroll
    for (int o = 1; o < 64; o <<= 1) { ma = fmaxf(ma, __shfl_xor(ma, o)); mb = fmaxf(mb, __shfl_xor(mb, o)); }
    const float sca = ma > 0.f ? ma * (1.0f / 127.0f) : 1.0f, scb = mb > 0.f ? mb * (1.0f / 127.0f) : 1.0f, ia = 1.0f / sca, ib = 1.0f / scb;
    if (lane == 0) { *sa = sca; *sb = scb; }
#pragma unroll
    for (int j = 0; j < 16; ++j) {
        if (j < JQ) { ((GAS unsigned*)oa + lane)[64 * j] = q4_pack(va[j].x, va[j].y, va[j].z, va[j].w, ia); ((GAS unsigned*)ob + lane)[64 * j] = q4_pack(vb[j].x, vb[j].y, vb[j].z, vb[j].w, ib); }
        else { ((GAS unsigned long long*)(oa - KQ) + lane)[64 * j] = (unsigned long long)pk2(va[j].x, va[j].y) | ((unsigned long long)pk2(va[j].z, va[j].w) << 32);
               ((GAS unsigned long long*)(ob - KQ) + lane)[64 * j] = (unsigned long long)pk2(vb[j].x, vb[j].y) | ((unsigned long long)pk2(vb[j].z, vb[j].w) << 32); } }
}
template <int KQ>
__device__ __forceinline__ void tr_gu_mixed(const float* W, int sel, bf16* WM, bf16* TMP, int item, LAS float* scr, int lane, const float* kgain = nullptr) {
    constexpr int nblk = FF / 32; const int kb = item / nblk, nb = item % nblk, n0 = 32 * nb, drow = (n0 >> 7) * 256 + sel * 128 + (n0 & 127);
    if (64 * kb < KQ) transpose_item(W, FF, TMP, KQ, 64 * kb, n0, drow, 64 * kb, scr, lane, kgain);
    else transpose_item(W, FF, WM, (KQ + (DM - KQ) * 2) / 2, 64 * kb, n0, drow, 64 * kb - KQ / 2, scr, lane, kgain);
}
__device__ __forceinline__ int ss_of_row(int row) { const int r = row & 255; return pg8::ss_index(row >> 8, (r >> 6) & 1, r & 15, r >> 7, (r >> 4) & 3); }
__device__ __forceinline__ void qk_norm_rope_row(bf16* __restrict__ hm, size_t m, int t, const float* __restrict__ qg, const float* __restrict__ kg, int lane) {
    const int sub = lane & 15, hq = lane >> 4;
    const int axis = sub >> 3, pos = axis ? (t & 63) : (t >> 6);
    float cs[8], sn[8];
#pragma unroll
    for (int e = 0; e < 8; ++e) { const int i = 8 * (sub & 3) + e;
        const float inv = exp2f(-(float)i * (13.287712379549449f / 32.0f));
        const float ang = (float)pos * inv; const float rev = ang * 0.15915494309189535f;
        cs[e] = __builtin_amdgcn_cosf(rev); sn[e] = __builtin_amdgcn_sinf(rev); }
    const bool lo_half = (sub & 4) == 0;
    float gq[8], gk[8];
#pragma unroll
    for (int e = 0; e < 8; ++e) { gq[e] = qg[sub * 8 + e]; gk[e] = kg[sub * 8 + e]; }
#pragma unroll
    for (int it = 0; it < 5; ++it) {
        const int head = it * 4 + hq;
        GAS v4u* p = (GAS v4u*)(hm + ((size_t)head * M + m) * HD + sub * 8);
        const v4u w = *p;
        float x[8]; x[0] = pg8::bf_lo(w.x); x[1] = pg8::bf_hi(w.x); x[2] = pg8::bf_lo(w.y); x[3] = pg8::bf_hi(w.y); x[4] = pg8::bf_lo(w.z); x[5] = pg8::bf_hi(w.z); x[6] = pg8::bf_lo(w.w); x[7] = pg8::bf_hi(w.w);
        float ss = 0.f;
#pragma unroll
        for (int e = 0; e < 8; ++e) ss += x[e] * x[e];
        ss += __shfl_xor(ss, 1); ss += __shfl_xor(ss, 2); ss += __shfl_xor(ss, 4); ss += __shfl_xor(ss, 8);
        const float rstd = 1.0f / sqrtf(ss * (1.f / HD) + RMS_EPS);
        float y[8], r[8];
#pragma unroll
        for (int e = 0; e < 8; ++e) y[e] = x[e] * rstd * (it < 4 ? gq[e] : gk[e]);
#pragma unroll
        for (int e = 0; e < 8; ++e) { const float pr = __shfl_xor(y[e], 4);
            r[e] = lo_half ? (y[e] * cs[e] - pr * sn[e]) : (pr * sn[e] + y[e] * cs[e]); }
        v4u o; o.x = pk2(r[0], r[1]); o.y = pk2(r[2], r[3]); o.z = pk2(r[4], r[5]); o.w = pk2(r[6], r[7]);
        *p = o;
    }
}
__device__ __forceinline__ void merge_row(const bf16* __restrict__ OG, const float* __restrict__ LSE, bf16* __restrict__ yrow, size_t m, int lane) {
    const int head = lane >> 3;
    float l[3];
    const size_t mg[3] = {m, (size_t)pg8::dil_row((int)m, 2), (size_t)pg8::dil_row((int)m, 4)};
#pragma unroll
    for (int g = 0; g < 3; ++g) l[g] = LSE[((size_t)g * M + mg[g]) * 8 + head];
    const float mx = fmaxf(l[0], fmaxf(l[1], l[2]));
    float e[3]; float es = 0.f;
#pragma unroll
    for (int g = 0; g < 3; ++g) { e[g] = __expf(l[g] - mx); es += e[g]; }
    const float inv = 1.0f / es;
    float acc[16];
#pragma unroll
    for (int i = 0; i < 16; ++i) acc[i] = 0.f;
#pragma unroll
    for (int g = 0; g < 3; ++g) { const float a = e[g] * inv; const GAS v4u* p = (const GAS v4u*)(OG + ((size_t)g * M + mg[g]) * 1024 + lane * 16);
#pragma unroll
        for (int h = 0; h < 2; ++h) { const v4u w = p[h];
            acc[8 * h + 0] += a * pg8::bf_lo(w.x); acc[8 * h + 1] += a * pg8::bf_hi(w.x); acc[8 * h + 2] += a * pg8::bf_lo(w.y); acc[8 * h + 3] += a * pg8::bf_hi(w.y);
            acc[8 * h + 4] += a * pg8::bf_lo(w.z); acc[8 * h + 5] += a * pg8::bf_hi(w.z); acc[8 * h + 6] += a * pg8::bf_lo(w.w); acc[8 * h + 7] += a * pg8::bf_hi(w.w); } }
    GAS v4u* o = (GAS v4u*)(yrow + lane * 16);
#pragma unroll
    for (int h = 0; h < 2; ++h) { v4u w; w.x = pk2(acc[8 * h + 0], acc[8 * h + 1]); w.y = pk2(acc[8 * h + 2], acc[8 * h + 3]); w.z = pk2(acc[8 * h + 4], acc[8 * h + 5]); w.w = pk2(acc[8 * h + 6], acc[8 * h + 7]); o[h] = w; }
}

struct Args { const float* in[17]; float* out; unsigned char* ws; int ph_lo, ph_hi; };
enum { I_X = 0, I_GFFN1, I_W1G, I_W1U, I_W1D, I_GMIX, I_WIN, I_QN, I_KN, I_WBA, I_WBB, I_WOUT, I_GFFN2, I_W2G, I_W2U, I_W2D, I_GFIN };

__global__ void __launch_bounds__(NWAVES * 64, 2) hyb_fwd(Args args) {
    extern __shared__ __attribute__((aligned(16))) unsigned char lds_raw[];
    LAS unsigned char* lds = (LAS unsigned char*)lds_raw;
    volatile LAS unsigned* MISC = (volatile LAS unsigned*)(lds + MISC_OFF);
    const int wave = __builtin_amdgcn_readfirstlane((int)threadIdx.x >> 6);
#define lane lane_id()
#define tid ((int)(wave * 64 + lane_id()))
    const int G = gridDim.x; const int bx = blockIdx.x; const int vcu = (G % 8 == 0) ? (bx % 8) * (G / 8) + bx / 8 : bx;
    unsigned char* ws = args.ws;
    gu32* ctl = (gu32*)(ws + WS_CTL);
    bf16* WGU = (bf16*)(ws + WS_WGU); bf16* WDN = (bf16*)(ws + WS_WDN); bf16* WIN_t = (bf16*)(ws + WS_WIN); bf16* WBR = (bf16*)(ws + WS_WBR); bf16* WOUT = (bf16*)(ws + WS_WOUT);
    bf16* XN = (bf16*)(ws + WS_XN); bf16* HMB = (bf16*)(ws + WS_BIG); unsigned char* GATES = (unsigned char*)(ws + WS_BIG + 384 * MiB); bf16* HID = (bf16*)(ws + WS_BIG); bf16* Y = (bf16*)(ws + WS_Y); bf16* OG = (bf16*)(ws + WS_OG); float* LSE = (float*)(ws + WS_LSE);
    float* Hs = args.out;
    for (int u = tid; u < (LDS_BYTES - LDSCTL_OFF) / 4; u += NWAVES * 64) ((LAS unsigned*)(lds + LDSCTL_OFF))[u] = 0u;
    __syncthreads();
    XcdBarrier bar = xcd_barrier_post((unsigned*)(ctl + CW_BAR), MISC + 8);
    const int lo = args.ph_lo, hi = args.ph_hi;
#define IN(k) (lo <= (k) && (k) < hi)
#define SEAM(k) do { if (IN(k) && IN((k) + 1)) xcd_barrier(bar); } while (0)
#ifndef PROBE_DUP
#define PROBE_DUP -1
#endif
#define REPS(k) ((PROBE_DUP == (k)) ? 2 : 1)
    const int gw = vcu * NWAVES + wave, NGW = G * NWAVES;
    LAS float* scr = (LAS float*)(lds + RING_OFF + wave * 16384);

    float* SS1 = (float*)(ctl + CW_SS1); float* SS2 = (float*)(ctl + CW_SS2); bf16* XN2 = (bf16*)(ws + WS_XN2);
    unsigned char* YQ = ws + WS_WIN; unsigned char* WBRQ = ws + WS_WIN + 64 * MiB; float* RSA = (float*)(ws + WS_WIN + 80 * MiB); float* CSA = RSA + M;
    if (IN(0)) for (int rep = 0; rep < REPS(0); ++rep) {
        unsigned char* XNM = (unsigned char*)XN; bf16* WGUM = WGU; bf16* TMPW = (bf16*)(ws + WS_BIG); float* RS1 = LSE; float* CS1 = LSE + M;
        constexpr int NIT = 2 * IT_GU + (IT_D1 - TAIL1_ITEMS);
        for (int it = gw; it < NIT; it += NGW) {
            int r = it;
            if (r < IT_GU) { tr_gu_mixed<KQ1>(args.in[I_W1G], 0, WGUM, TMPW, r, scr, lane); continue; } r -= IT_GU;
            if (r < IT_GU) { tr_gu_mixed<KQ1>(args.in[I_W1U], 1, WGUM, TMPW, r, scr, lane); continue; } r -= IT_GU;
            conv_deferred(TAIL1_ITEMS + r, args.in, WIN_t, WOUT, WBR, WDN, scr, lane);
        }
        for (int m = gw; m < M; m += 2 * NGW) { const int m2 = (m + NGW < M) ? m + NGW : m;
            rms_row_mixed2<KQ1>(args.in[I_X] + (size_t)m * DM, args.in[I_X] + (size_t)m2 * DM, args.in[I_GFFN1], XNM + (size_t)m * ROWB1, XNM + (size_t)m2 * ROWB1, RS1 + ss_of_row(m), RS1 + ss_of_row(m2), lane); }
        xcd_barrier(bar);
        for (int n = 2 * gw; n < 2 * FF; n += 2 * NGW)
            quant_row2<KQ1 / 512>(TMPW + (size_t)n * KQ1, TMPW + (size_t)(n + 1) * KQ1, (unsigned char*)WGUM + (size_t)n * ROWB1, (unsigned char*)WGUM + (size_t)(n + 1) * ROWB1, CS1 + n, CS1 + n + 1, 1.0f, 1.0f, lane);
    }
    SEAM(0);
    if (IN(1)) for (int rep = 0; rep < REPS(1); ++rep) {
        pg8::Gemm g{(const pg8::bf16_t*)XN, WGU, M, 2 * FF, ROWB1 / 2, ROWB1 / 2, ROWB1 / 2, 256, 256}; pg8::StaticOrder S; S.init(M, 2 * FF, G, bx);
        pg8::EpiSwiGLUQ E{{HID, M, nullptr, 0.f, 0.f}, LSE, LSE + M};
        pg8::gemm_phase<pg8::EpiSwiGLUQ, pg8::StaticOrder, true, false, KQ1 / 128>(lds + RING_OFF, g, S, E, wave);
        TAIL_WORK((M / 256) * (2 * FF / 256), TAIL1_ITEMS, conv_deferred(it, args.in, WIN_t, WOUT, WBR, WDN, scr, lane));
    }
    SEAM(1);
    if (IN(2)) {
        pg8::Gemm g{HID, WDN, M, DM, FF, 128, 128, (size_t)M * 256, (size_t)DM * 256}; pg8::BandOrder S; S.init(M, DM, G, bx);
        pg8::EpiRes<false, true, true> E{args.in[I_X], DM, XN, DM, 0.5f, SS1};
        pg8::gemm_phase<pg8::EpiRes<false, true, true>, pg8::BandOrder, true>(lds + RING_OFF, g, S, E, wave);
    }
    SEAM(2);
    if (IN(3)) for (int rep = 0; rep < REPS(3); ++rep) {
        unsigned char* XQ = (unsigned char*)(ws + WS_XN2); unsigned char* WQ = (unsigned char*)(ws + WS_WGU);
        float* RS = LSE; float* CS = LSE + M;
        { const int NR = M + INW;
          for (int r = 2 * gw; r < NR; r += 2 * NGW) {
              if (r < M) quant_row2(XN + (size_t)r * DM, XN + (size_t)(r + 1) * DM, XQ + (size_t)r * DM, XQ + (size_t)(r + 1) * DM, RS + ss_of_row(r), RS + ss_of_row(r + 1),
                                    1.0f / sqrtf(SS1[ss_of_row(r)] * (1.0f / DM) + RMS_EPS), 1.0f / sqrtf(SS1[ss_of_row(r + 1)] * (1.0f / DM) + RMS_EPS), lane);
              else { const int n = r - M; quant_row2(WIN_t + (size_t)n * DM, WIN_t + (size_t)(n + 1) * DM, WQ + (size_t)n * DM, WQ + (size_t)(n + 1) * DM, CS + n, CS + n + 1, 1.0f, 1.0f, lane); } } }
        xcd_barrier(bar);
        pg8::Gemm g{(const pg8::bf16_t*)XQ, (const pg8::bf16_t*)WQ, M, INW, DM / 2, DM / 2, DM / 2, 256, 256}; pg8::StaticOrder S; S.init(M, INW, G, bx);
        pg8::EpiBf16Q E{HMB, M, GATES, GW, RS, CS, (C_QKVB + 3072) / 256, (C_QKVB + 6144) / 256, C_GA / 256};
        pg8::gemm_phase<pg8::EpiBf16Q, pg8::StaticOrder, true, true>(lds + RING_OFF, g, S, E, wave);
    }
    SEAM(3);
    if (IN(4)) {
        for (int m = gw; m < M; m += NGW) qk_norm_rope_row(HMB, (size_t)m, m & (T - 1), args.in[I_QN], args.in[I_KN], lane);
        constexpr int NIT = 2 * IT_GU + (IT_DN - TAIL9_ITEMS);
        for (int it = gw; it < NIT; it += NGW) {
            int r = it;
            if (r < IT_GU) { tr_gu(args.in[I_W2G], 0, WGU, r, scr, lane, args.in[I_GFFN2]); continue; } r -= IT_GU;
            if (r < IT_GU) { tr_gu(args.in[I_W2U], 1, WGU, r, scr, lane, args.in[I_GFFN2]); continue; } r -= IT_GU;
            tr_blocked(args.in[I_W2D], DM, WDN, TAIL9_ITEMS + r, scr, lane);
        }
    }
    SEAM(4);
    if (IN(5)) for (int rep = 0; rep < REPS(5); ++rep) {
        LAS char* alds = (LAS char*)(lds + RING_OFF);
        for (int u = vcu; u < BATCH * 16 * 16; u += G) {
            const int qb = u & 15, h = (u >> 4) & 15, b = u >> 8, kvh = h >> 2;
            const size_t row0 = (size_t)b * T;
            att::dense_unit(HMB + ((size_t)(S_QA + h) * M + row0 + qb * 256) * HD, HMB + ((size_t)(S_KA + kvh) * M + row0) * HD, HMB + ((size_t)(S_VA + kvh) * M + row0) * HD,
                            Y + (row0 + qb * 256) * YW + h * HD, YW, T / 64, alds, wave);
        }
        for (int u = vcu; u < BATCH * 3 * 8 * 16; u += G) {
            const int sub = u & 15, h = (u >> 4) & 7, bg = u >> 7, grp = bg % 3, b = bg / 3;
            const int dsh = 2 * grp, d = 1 << dsh, L = T >> dsh, nqb = L >> 8;
            const int res = sub / nqb, i0 = (sub % nqb) * 256;
            const float slope = exp2f(-8.0f * (float)(grp * 8 + h + 1) / 24.0f);
            const size_t row0 = (size_t)b * T + (size_t)res * L;
            const int sq = S_B + grp * 24 + h;
            att::win_unit(HMB + ((size_t)sq * M + row0 + i0) * HD, HMB + ((size_t)(sq + 8) * M + row0) * HD, HMB + ((size_t)(sq + 16) * M + row0) * HD,
                          OG + ((size_t)grp * M + row0 + i0) * 1024 + h * HD, 1024, LSE + ((size_t)grp * M + row0 + i0) * 8 + h, 8, i0, L, slope * (float)d / att::SCALE, alds, wave);
        }
    }
    SEAM(5);
    if (IN(6)) {
        for (int m = gw; m < M; m += NGW) merge_row(OG, LSE, (bf16*)(YQ + (size_t)m * 4096 + 2048), (size_t)m, lane);
        for (int r = 2 * gw; r < M + DM; r += 2 * NGW) {
            if (r < M) quant_row2<4>(Y + (size_t)r * YW, Y + (size_t)(r + 1) * YW, YQ + (size_t)r * 4096, YQ + (size_t)(r + 1) * 4096, RSA + ss_of_row(r), RSA + ss_of_row(r + 1), 1.0f, 1.0f, lane);
            else { const int n = r - M;
                quant_row2<4>(WBR + (size_t)n * YW, WBR + (size_t)(n + 1) * YW, WBRQ + (size_t)n * 4096, WBRQ + (size_t)(n + 1) * 4096, CSA + n, CSA + n + 1, 1.0f, 1.0f, lane);
#pragma unroll
                for (int q = 0; q < 2; ++q) { const GAS v4u* sp = (const GAS v4u*)(WBR + (size_t)(n + q) * YW + 2048) + lane; GAS v4u* dp = (GAS v4u*)(WBRQ + (size_t)(n + q) * 4096 + 2048) + lane; dp[0] = sp[0]; dp[64] = sp[64]; } } }
    }
    SEAM(6);
    if (IN(7)) {
        pg8::Gemm g{(const pg8::bf16_t*)YQ, (const pg8::bf16_t*)WBRQ, M, DM, 2048, 2048, 2048, 256, 256}; pg8::StaticOrder S; S.init(M, DM, G, bx);
        pg8::EpiGateABQ E{{GATES, GATES + DM, GW, XN2, DM}, RSA, CSA};
        pg8::gemm_phase<pg8::EpiGateABQ, pg8::StaticOrder, true, false, 16>(lds + RING_OFF, g, S, E, wave);
    }
    SEAM(7);
    if (IN(8)) {
        unsigned char* XQ = (unsigned char*)(ws + WS_OG); unsigned char* WQ = (unsigned char*)(ws + WS_Y);
        float* RS = LSE; float* CS = LSE + M;
        { const int NR = M + DM;
          for (int r = 2 * gw; r < NR; r += 2 * NGW) {
              if (r < M) quant_row2(XN2 + (size_t)r * DM, XN2 + (size_t)(r + 1) * DM, XQ + (size_t)r * DM, XQ + (size_t)(r + 1) * DM, RS + ss_of_row(r), RS + ss_of_row(r + 1), 1.0f, 1.0f, lane);
              else { const int n = r - M; quant_row2(WOUT + (size_t)n * DM, WOUT + (size_t)(n + 1) * DM, WQ + (size_t)n * DM, WQ + (size_t)(n + 1) * DM, CS + n, CS + n + 1, 1.0f, 1.0f, lane); } } }
        xcd_barrier(bar);
        pg8::Gemm g{(const pg8::bf16_t*)XQ, (const pg8::bf16_t*)WQ, M, DM, DM / 2, DM / 2, DM / 2, 256, 256}; pg8::StaticOrder S; S.init(M, DM, G, bx);
        pg8::EpiResQ E{XN, DM, XN, DM, RS, CS, SS2};
        pg8::gemm_phase<pg8::EpiResQ, pg8::StaticOrder, true, true>(lds + RING_OFF, g, S, E, wave);
    }
    SEAM(8);
    if (IN(9)) {
        pg8::Gemm g{XN, WGU, M, 2 * FF, DM, DM, DM, 256, 256}; pg8::StaticOrder S; S.init(M, 2 * FF, G, bx);
        pg8::EpiSwiGLU E{HID, M, SS2, 1.0f / DM, RMS_EPS};
        pg8::gemm_phase<pg8::EpiSwiGLU, pg8::StaticOrder, true>(lds + RING_OFF, g, S, E, wave);
        if (TAIL9_ITEMS > 0) TAIL_WORK((M / 256) * (2 * FF / 256), TAIL9_ITEMS, tr_blocked(args.in[I_W2D], DM, WDN, it, scr, lane));
    }
    SEAM(9);
    if (IN(10)) {
        pg8::Gemm g{HID, WDN, M, DM, FF, 128, 128, (size_t)M * 256, (size_t)DM * 256}; pg8::BandOrder S; S.init(M, DM, G, bx);
        pg8::EpiRes<true, false, false> E{XN, DM, Hs, DM, 0.5f, nullptr};
        pg8::gemm_phase<pg8::EpiRes<true, false, false>, pg8::BandOrder, true>(lds + RING_OFF, g, S, E, wave);
    }
    SEAM(10);
    if (IN(11)) {
        { int m = gw;
          for (; m + NGW < M; m += 2 * NGW) rms_row2<false>(Hs + (size_t)m * DM, Hs + (size_t)(m + NGW) * DM, args.in[I_GFIN], Hs + (size_t)m * DM, Hs + (size_t)(m + NGW) * DM, lane);
          if (m < M) rms_row_to_f32(Hs + (size_t)m * DM, args.in[I_GFIN], Hs + (size_t)m * DM, lane); }
    }
#undef IN
#undef SEAM
#undef lane
#undef tid
}

#ifndef MK_PER_PHASE
#define MK_PER_PHASE 0
#endif
extern "C" void kernel_launch(void* const* d_in, const int* in_sizes, int n_in, void* d_out, int out_size, void* d_ws, size_t ws_size, hipStream_t stream) {
    static int grid = 0;
    if (grid == 0) {
        if (n_in != 17 || in_sizes[0] != M * DM || out_size != M * DM || ws_size < WS_END) {
            fprintf(stderr, "kernel_launch: shape mismatch: n_in %d in0 %d out %d ws %zu (need >= %zu); nothing launched\n", n_in, n_in > 0 ? in_sizes[0] : -1, out_size, ws_size, (size_t)WS_END); grid = -1; return; }
        int dev = 0, cus = 0, per_cu = 0;
        if (hipGetDevice(&dev) != hipSuccess || hipDeviceGetAttribute(&cus, hipDeviceAttributeMultiprocessorCount, dev) != hipSuccess) { fprintf(stderr, "kernel_launch: device query failed\n"); grid = -1; return; }
        if (hipFuncSetAttribute((const void*)hyb_fwd, hipFuncAttributeMaxDynamicSharedMemorySize, LDS_BYTES) != hipSuccess) { fprintf(stderr, "kernel_launch: hipFuncSetAttribute failed\n"); grid = -1; return; }
        if (hipOccupancyMaxActiveBlocksPerMultiprocessor(&per_cu, (const void*)hyb_fwd, NWAVES * 64, LDS_BYTES) != hipSuccess || per_cu < 1)
            fprintf(stderr, "kernel_launch: note: occupancy query reports %d workgroups per CU\n", per_cu);
        (void)hipGetLastError();
        grid = cus;
    }
    if (grid < 0) return;
    if (hipMemsetAsync((char*)d_ws + WS_CTL, 0, CTL_ZERO_BYTES, stream) != hipSuccess) { fprintf(stderr, "kernel_launch: memset failed\n"); return; }
    Args a{};
    for (int i = 0; i < 17; ++i) a.in[i] = (const float*)d_in[i];
    a.out = (float*)d_out; a.ws = (unsigned char*)d_ws;
#if MK_PER_PHASE
    for (int p = 0; p < N_PHASES; ++p) { a.ph_lo = p; a.ph_hi = p + 1; hipLaunchKernelGGL(hyb_fwd, dim3(grid), dim3(NWAVES * 64), LDS_BYTES, stream, a); }
#else
    a.ph_lo = 0; a.ph_hi = N_PHASES;
    hipLaunchKernelGGL(hyb_fwd, dim3(grid), dim3(NWAVES * 64), LDS_BYTES, stream, a);
#endif
    const hipError_t le = hipPeekAtLastError();
    if (le != hipSuccess) fprintf(stderr, "kernel_launch: launch failed: %s\n", hipGetErrorName(le));
}
```

```cpp
#include <hip/hip_runtime.h>
#include <cstdio>
#include <cstdint>

__device__ __forceinline__ int lane_id() { int l; asm volatile("v_mbcnt_lo_u32_b32 %0, -1, 0\n\tv_mbcnt_hi_u32_b32 %0, -1, %0" : "=v"(l)); return l; }
namespace pg8 {
#define PG8_LAS __attribute__((address_space(3)))
typedef unsigned short bf16_t;
typedef short bf16x8 __attribute__((ext_vector_type(8)));
typedef float f32x4 __attribute__((ext_vector_type(4)));
typedef unsigned u32x4 __attribute__((ext_vector_type(4)));
typedef int i32x4 __attribute__((ext_vector_type(4)));
template <bool I8> struct AccT { typedef f32x4 type; };
template <> struct AccT<true> { typedef i32x4 type; };
constexpr int BM = 256, BK = 64, HALF = 128, HTB = HALF * BK * 2  , STAGE_BYTES = 8 * HTB, NXCD = 8, WGM = 8;

__host__ __device__ __forceinline__ int lds_byte(int r, int c) { const int rr = r & 7, g = c >> 3; return (r >> 3) * 1024 + (rr * 8 + (g ^ (2 * (rr >> 1)))) * 16 + (c & 7) * 2; }
__host__ __device__ __forceinline__ void stage_rc(int b, int& R, int& C) { const int p = (b % 1024) / 16, rr = p >> 3, g = (p & 7) ^ (2 * (rr >> 1)); R = (b / 1024) * 8 + rr; C = g * 8 + (b % 16) / 2; }
__host__ __device__ __forceinline__ int perm32(int rho) { const int n = rho >> 4, i = rho & 15; return 8 * (i >> 2) + 4 * n + (i & 3); }

struct Unit { int pm, pn; };
struct Gemm { const bf16_t* A; const bf16_t* Bt; int M, N, K, lda, ldb; size_t kpA, kpB; };

struct StaticOrder {
    int nM, nN, nwg, G, c;
    __host__ __device__ void init(int M, int N, int G_, int c_) { nM = M / BM; nN = N / BM; nwg = nM * nN; G = G_; c = c_; }
    __host__ __device__ bool next(int i, Unit& u) const {
        const long L = (long)i * G + c; if (L >= nwg) return false;
        int wgid = (int)L; { const int q = nwg / NXCD, r = nwg % NXCD, xcd = wgid % NXCD, off = wgid / NXCD; wgid = (xcd < r ? xcd * (q + 1) : r * (q + 1) + (xcd - r) * q) + off; }
        const int nig = WGM * nN, gid = wgid / nig, fm = gid * WGM, gsz = (nM - fm) < WGM ? (nM - fm) : WGM;
        u.pm = fm + ((wgid % nig) % gsz); u.pn = (wgid % nig) / gsz; return true;
    }
    __device__ __forceinline__ void a_ready(const Unit&) const {}
    __device__ __forceinline__ void done(const Unit&) const {}
};

struct BandOrder {
    StaticOrder so; int G, c;
    __host__ __device__ void init(int M, int N, int G_, int c_) { so.init(M, N, G_, c_); G = G_; c = c_; }
    __host__ __device__ bool next(int i, Unit& u) const {
        if (G != 256 || so.nM != 64 || so.nN != 16) return so.next(i, u);
        if (i >= 4) return false;
        const int x = c & 7, j = c >> 3;
        u.pm = 16 * i + 4 * (x & 3) + (j & 3); u.pn = 8 * (x >> 2) + (j >> 2); return true;
    }
    __device__ __forceinline__ void a_ready(const Unit&) const {}
    __device__ __forceinline__ void done(const Unit&) const {}
};

__device__ __forceinline__ unsigned cvt_pk_bf16(float lo, float hi) { unsigned r; asm volatile("v_cvt_pk_bf16_f32 %0, %1, %2" : "=v"(r) : "v"(lo), "v"(hi)); return r; }
__device__ __forceinline__ float bf_lo(unsigned w) { return __uint_as_float(w << 16); }
__device__ __forceinline__ float bf_hi(unsigned w) { return __uint_as_float(w & 0xffff0000u); }
__device__ __forceinline__ float sigmoid_f(float x) { return __builtin_amdgcn_rcpf(1.0f + __builtin_amdgcn_exp2f(-1.4426950408889634f * x)); }

__device__ __forceinline__ int ss_index(int pm, int wr, int fr, int ai, int m) { return pm * 256 + wr * 128 + fr * 8 + ai * 4 + m; }
__device__ __forceinline__ void load_rstd8(const float* ss, int pm, int wr, int fr, float inv_n, float eps, float (&sc)[2][4]) {
    const f32x4 a = *(const f32x4*)(ss + ss_index(pm, wr, fr, 0, 0)), b = *(const f32x4*)(ss + ss_index(pm, wr, fr, 1, 0));
#pragma unroll
    for (int m = 0; m < 4; ++m) { sc[0][m] = __builtin_amdgcn_rsqf(a[m] * inv_n + eps); sc[1][m] = __builtin_amdgcn_rsqf(b[m] * inv_n + eps); }
}
__host__ __device__ __forceinline__ int dil_row(int row, int dsh) { const int t = row & 4095; return (row & ~4095) | ((t & ((1 << dsh) - 1)) << (12 - dsh)) | (t >> dsh); }
struct EpiBf16 {
    static constexpr bool PERM = true, AFTER_DRAIN = false;
    bf16_t* HM; int nrows; unsigned char* G; int ldg; const float* ss; float inv_n, eps; int pn_d4, pn_d16, pn_gate;
    __device__ __forceinline__ void operator()(const f32x4 (&acc)[2][2][4][2], const Unit& u, int wr, int wc, int fr, int fq) const {
        const int row0 = u.pm * BM + wr * 64 + fr, cw = wc * 32 + 8 * fq;
        const bool is_gate = u.pn >= pn_gate;
        const int dsh = (u.pn >= pn_d4 && !is_gate) ? (u.pn >= pn_d16 ? 4 : 2) : 0;
        float scv[2][4];
        load_rstd8(ss, u.pm, wr, fr, inv_n, eps, scv);
#pragma unroll
        for (int ai = 0; ai < 2; ++ai)
#pragma unroll
            for (int m = 0; m < 4; ++m) { const int row = row0 + ai * HALF + m * 16; const float sc = scv[ai][m];
#pragma unroll
                for (int bj = 0; bj < 2; ++bj) { const f32x4 v0 = acc[ai][bj][m][0] * sc, v1 = acc[ai][bj][m][1] * sc;
                    if (is_gate) {
                        unsigned q[8];
#pragma unroll
                        for (int e = 0; e < 4; ++e) { q[e] = (unsigned)(sigmoid_f(v0[e]) * 255.0f + 0.5f); q[4 + e] = (unsigned)(sigmoid_f(v1[e]) * 255.0f + 0.5f); }
                        const unsigned long long pk = (unsigned long long)(q[0] | (q[1] << 8) | (q[2] << 16) | (q[3] << 24)) | ((unsigned long long)(q[4] | (q[5] << 8) | (q[6] << 16) | (q[7] << 24)) << 32);
                        *(unsigned long long*)(G + (size_t)row * ldg + (u.pn - pn_gate) * BM + bj * HALF + cw) = pk;
                    } else {
                        u32x4 w; w.x = cvt_pk_bf16(v0[0], v0[1]); w.y = cvt_pk_bf16(v0[2], v0[3]); w.z = cvt_pk_bf16(v1[0], v1[1]); w.w = cvt_pk_bf16(v1[2], v1[3]);
                        *(u32x4*)(HM + ((size_t)(2 * u.pn + bj) * nrows + dil_row(row, dsh)) * HALF + cw) = w; } } }
    }
};
struct EpiBf16Q {
    static constexpr bool PERM = true, AFTER_DRAIN = false;
    bf16_t* HM; int nrows; unsigned char* G; int ldg; const float* rs; const float* cs; int pn_d4, pn_d16, pn_gate;
    __device__ __forceinline__ void operator()(const i32x4 (&acc)[2][2][4][2], const Unit& u, int wr, int wc, int fr, int fq) const {
        const int row0 = u.pm * BM + wr * 64 + fr, cw = wc * 32 + 8 * fq;
        const bool is_gate = u.pn >= pn_gate;
        const int dsh = (u.pn >= pn_d4 && !is_gate) ? (u.pn >= pn_d16 ? 4 : 2) : 0;
        float scv[2][4];
        { const f32x4 a = *(const f32x4*)(rs + ss_index(u.pm, wr, fr, 0, 0)), b = *(const f32x4*)(rs + ss_index(u.pm, wr, fr, 1, 0));
#pragma unroll
          for (int m = 0; m < 4; ++m) { scv[0][m] = a[m]; scv[1][m] = b[m]; } }
        f32x4 cc[2][2];
#pragma unroll
        for (int bj = 0; bj < 2; ++bj) { const float* cp = cs + u.pn * BM + bj * HALF + cw; cc[bj][0] = *(const f32x4*)cp; cc[bj][1] = *(const f32x4*)(cp + 4); }
#pragma unroll
        for (int ai = 0; ai < 2; ++ai)
#pragma unroll
            for (int m = 0; m < 4; ++m) { const int row = row0 + ai * HALF + m * 16; const float sc = scv[ai][m];
#pragma unroll
                for (int bj = 0; bj < 2; ++bj) { const i32x4 i0 = acc[ai][bj][m][0], i1 = acc[ai][bj][m][1];
                    const f32x4 v0 = (f32x4){(float)i0[0], (float)i0[1], (float)i0[2], (float)i0[3]} * cc[bj][0] * sc, v1 = (f32x4){(float)i1[0], (float)i1[1], (float)i1[2], (float)i1[3]} * cc[bj][1] * sc;
                    if (is_gate) {
                        unsigned q[8];
#pragma unroll
                        for (int e = 0; e < 4; ++e) { q[e] = (unsigned)(sigmoid_f(v0[e]) * 255.0f + 0.5f); q[4 + e] = (unsigned)(sigmoid_f(v1[e]) * 255.0f + 0.5f); }
                        const unsigned long long pk = (unsigned long long)(q[0] | (q[1] << 8) | (q[2] << 16) | (q[3] << 24)) | ((unsigned long long)(q[4] | (q[5] << 8) | (q[6] << 16) | (q[7] << 24)) << 32);
                        *(unsigned long long*)(G + (size_t)row * ldg + (u.pn - pn_gate) * BM + bj * HALF + cw) = pk;
                    } else {
                        u32x4 w; w.x = cvt_pk_bf16(v0[0], v0[1]); w.y = cvt_pk_bf16(v0[2], v0[3]); w.z = cvt_pk_bf16(v1[0], v1[1]); w.w = cvt_pk_bf16(v1[2], v1[3]);
                        *(u32x4*)(HM + ((size_t)(2 * u.pn + bj) * nrows + dil_row(row, dsh)) * HALF + cw) = w; } } }
    }
};
struct EpiSwiGLU {
    static constexpr bool PERM = true, AFTER_DRAIN = false;
    bf16_t* O; int nrows; const float* ss; float inv_n, eps;
    __device__ __forceinline__ void operator()(const f32x4 (&acc)[2][2][4][2], const Unit& u, int wr, int wc, int fr, int fq) const {
        const int row0 = u.pm * BM + wr * 64 + fr, col0 = wc * 32 + 8 * fq;
        bf16_t* Ob = O + (size_t)u.pn * nrows * HALF;
        float scv[2][4];
        if (ss) load_rstd8(ss, u.pm, wr, fr, inv_n, eps, scv);
#pragma unroll
        for (int ai = 0; ai < 2; ++ai)
#pragma unroll
            for (int m = 0; m < 4; ++m) { const int row = row0 + ai * HALF + m * 16; bf16_t* rowp = Ob + (size_t)row * HALF + col0;
                const float sc = ss ? scv[ai][m] : 1.0f;
                float h[8];
#pragma unroll
                for (int n = 0; n < 2; ++n)
#pragma unroll
                    for (int e = 0; e < 4; ++e) { const float g = acc[ai][0][m][n][e] * sc, up = acc[ai][1][m][n][e] * sc; h[4 * n + e] = g * sigmoid_f(g) * up; }
                u32x4 w; w.x = cvt_pk_bf16(h[0], h[1]); w.y = cvt_pk_bf16(h[2], h[3]); w.z = cvt_pk_bf16(h[4], h[5]); w.w = cvt_pk_bf16(h[6], h[7]);
                *(u32x4*)rowp = w; }
    }
};
struct EpiSwiGLUQ {
    static constexpr bool PERM = true, AFTER_DRAIN = false;
    EpiSwiGLU base; const float* rs; const float* cs;
    __device__ __forceinline__ void mid(f32x4 (&acc)[2][2][4][2], const Unit& u, int wr, int wc, int fr, int fq) const {
        const int col0 = u.pn * BM + wc * 32 + 8 * fq;
        f32x4 cc[2][2];
#pragma unroll
        for (int bj = 0; bj < 2; ++bj) { const float* cp = cs + col0 + bj * HALF; cc[bj][0] = *(const f32x4*)cp; cc[bj][1] = *(const f32x4*)(cp + 4); }
#pragma unroll
        for (int ai = 0; ai < 2; ++ai) { const f32x4 rsv = *(const f32x4*)(rs + ss_index(u.pm, wr, fr, ai, 0));
#pragma unroll
            for (int m = 0; m < 4; ++m)
#pragma unroll
                for (int bj = 0; bj < 2; ++bj)
#pragma unroll
                    for (int n = 0; n < 2; ++n)
#pragma unroll
                        for (int e = 0; e < 4; ++e) acc[ai][bj][m][n][e] = (float)__float_as_int(acc[ai][bj][m][n][e]) * (rsv[m] * cc[bj][n][e]); }
    }
    __device__ __forceinline__ void operator()(const f32x4 (&acc)[2][2][4][2], const Unit& u, int wr, int wc, int fr, int fq) const { base(acc, u, wr, wc, fr, fq); }
};
template <bool RES_BF16, bool OUT_BF16, bool STATS> struct EpiRes {
    static constexpr bool PERM = true, AFTER_DRAIN = false;
    const void* res; int ldr; void* out; int ldo; float alpha; float* ss;
    __device__ __forceinline__ void operator()(const f32x4 (&acc)[2][2][4][2], const Unit& u, int wr, int wc, int fr, int fq) const {
        const int row0 = u.pm * BM + wr * 64 + fr, col0 = u.pn * BM + wc * 32 + 8 * fq;
#pragma unroll
        for (int ai = 0; ai < 2; ++ai) {
            f32x4 rf[4][2][2]; u32x4 rb[4][2];
#pragma unroll
            for (int m = 0; m < 4; ++m) { const size_t ro = (size_t)(row0 + ai * HALF + m * 16) * ldr + col0;
#pragma unroll
                for (int bj = 0; bj < 2; ++bj) {
                    if constexpr (RES_BF16) rb[m][bj] = *(const u32x4*)((const bf16_t*)res + ro + bj * HALF);
                    else { rf[m][bj][0] = *(const f32x4*)((const float*)res + ro + bj * HALF); rf[m][bj][1] = *(const f32x4*)((const float*)res + ro + bj * HALF + 4); } } }
            __builtin_amdgcn_sched_barrier(0);
#pragma unroll
            for (int m = 0; m < 4; ++m) { const int row = row0 + ai * HALF + m * 16; const size_t oo = (size_t)row * ldo + col0;
                float sq = 0.f;
#pragma unroll
                for (int bj = 0; bj < 2; ++bj) { f32x4 r0, r1;
                    if constexpr (RES_BF16) { const u32x4 w = rb[m][bj]; r0 = (f32x4){bf_lo(w.x), bf_hi(w.x), bf_lo(w.y), bf_hi(w.y)}; r1 = (f32x4){bf_lo(w.z), bf_hi(w.z), bf_lo(w.w), bf_hi(w.w)}; }
                    else { r0 = rf[m][bj][0]; r1 = rf[m][bj][1]; }
                    const f32x4 h0 = r0 + acc[ai][bj][m][0] * alpha, h1 = r1 + acc[ai][bj][m][1] * alpha;
                    if constexpr (STATS) sq += ((h0[0] * h0[0] + h0[1] * h0[1]) + (h0[2] * h0[2] + h0[3] * h0[3])) + ((h1[0] * h1[0] + h1[1] * h1[1]) + (h1[2] * h1[2] + h1[3] * h1[3]));
                    if constexpr (OUT_BF16) { u32x4 w; w.x = cvt_pk_bf16(h0[0], h0[1]); w.y = cvt_pk_bf16(h0[2], h0[3]); w.z = cvt_pk_bf16(h1[0], h1[1]); w.w = cvt_pk_bf16(h1[2], h1[3]);
                        *(u32x4*)((bf16_t*)out + oo + bj * HALF) = w; }
                    else { *(f32x4*)((float*)out + oo + bj * HALF) = h0; *(f32x4*)((float*)out + oo + bj * HALF + 4) = h1; } }
                if constexpr (STATS) { sq += __shfl_xor(sq, 16); sq += __shfl_xor(sq, 32);
                    if (fq == 0) __hip_atomic_fetch_add(ss + ss_index(u.pm, wr, fr, ai, m), sq, __ATOMIC_RELAXED, __HIP_MEMORY_SCOPE_AGENT); } }
            __builtin_amdgcn_sched_barrier(0);
        }
    }
};
struct EpiResQ {
    static constexpr bool PERM = true, AFTER_DRAIN = false;
    const bf16_t* res; int ldr; bf16_t* out; int ldo; const float* rs; const float* cs; float* ss;
    __device__ __forceinline__ void operator()(const i32x4 (&acc)[2][2][4][2], const Unit& u, int wr, int wc, int fr, int fq) const {
        const int row0 = u.pm * BM + wr * 64 + fr, col0 = u.pn * BM + wc * 32 + 8 * fq;
        f32x4 cc[2][2];
#pragma unroll
        for (int bj = 0; bj < 2; ++bj) { const float* cp = cs + col0 + bj * HALF; cc[bj][0] = *(const f32x4*)cp; cc[bj][1] = *(const f32x4*)(cp + 4); }
#pragma unroll
        for (int ai = 0; ai < 2; ++ai) {
            u32x4 rb[4][2];
            const f32x4 rsv = *(const f32x4*)(rs + ss_index(u.pm, wr, fr, ai, 0));
#pragma unroll
            for (int m = 0; m < 4; ++m) { const size_t ro = (size_t)(row0 + ai * HALF + m * 16) * ldr + col0;
#pragma unroll
                for (int bj = 0; bj < 2; ++bj) rb[m][bj] = *(const u32x4*)(res + ro + bj * HALF); }
            __builtin_amdgcn_sched_barrier(0);
#pragma unroll
            for (int m = 0; m < 4; ++m) { const int row = row0 + ai * HALF + m * 16; const size_t oo = (size_t)row * ldo + col0; const float sc = rsv[m];
                float sq = 0.f;
#pragma unroll
                for (int bj = 0; bj < 2; ++bj) { const u32x4 w = rb[m][bj];
                    const f32x4 r0 = (f32x4){bf_lo(w.x), bf_hi(w.x), bf_lo(w.y), bf_hi(w.y)}, r1 = (f32x4){bf_lo(w.z), bf_hi(w.z), bf_lo(w.w), bf_hi(w.w)};
                    const i32x4 i0 = acc[ai][bj][m][0], i1 = acc[ai][bj][m][1];
                    const f32x4 h0 = r0 + (f32x4){(float)i0[0], (float)i0[1], (float)i0[2], (float)i0[3]} * cc[bj][0] * sc, h1 = r1 + (f32x4){(float)i1[0], (float)i1[1], (float)i1[2], (float)i1[3]} * cc[bj][1] * sc;
                    sq += ((h0[0] * h0[0] + h0[1] * h0[1]) + (h0[2] * h0[2] + h0[3] * h0[3])) + ((h1[0] * h1[0] + h1[1] * h1[1]) + (h1[2] * h1[2] + h1[3] * h1[3]));
                    u32x4 o; o.x = cvt_pk_bf16(h0[0], h0[1]); o.y = cvt_pk_bf16(h0[2], h0[3]); o.z = cvt_pk_bf16(h1[0], h1[1]); o.w = cvt_pk_bf16(h1[2], h1[3]);
                    *(u32x4*)(out + oo + bj * HALF) = o; }
                sq += __shfl_xor(sq, 16); sq += __shfl_xor(sq, 32);
                if (fq == 0) __hip_atomic_fetch_add(ss + ss_index(u.pm, wr, fr, ai, m), sq, __ATOMIC_RELAXED, __HIP_MEMORY_SCOPE_AGENT); }
            __builtin_amdgcn_sched_barrier(0);
        }
    }
};
struct EpiGateAB {
    static constexpr bool PERM = true, AFTER_DRAIN = false; static constexpr int MIDT = 32;
    const unsigned char* sigA; const unsigned char* sigB; int ldg; bf16_t* O; int ldc;
    __device__ __forceinline__ void mid(f32x4 (&acc)[2][2][4][2], const Unit& u, int wr, int wc, int fr, int fq) const {
        const int row0 = u.pm * BM + wr * 64 + fr, col0 = u.pn * BM + wc * 32 + 8 * fq;
#pragma unroll
        for (int ai = 0; ai < 2; ++ai) {
            unsigned long long ga[4][2], gb[4][2];
#pragma unroll
            for (int m = 0; m < 4; ++m) { const size_t ro = (size_t)(row0 + ai * HALF + m * 16) * ldg + col0;
#pragma unroll
                for (int bj = 0; bj < 2; ++bj) { ga[m][bj] = *(const unsigned long long*)(sigA + ro + bj * HALF); gb[m][bj] = *(const unsigned long long*)(sigB + ro + bj * HALF); } }
            __builtin_amdgcn_sched_barrier(0);
#pragma unroll
            for (int m = 0; m < 4; ++m)
#pragma unroll
                for (int bj = 0; bj < 2; ++bj) { const unsigned alo = (unsigned)ga[m][bj], ahi = (unsigned)(ga[m][bj] >> 32), blo = (unsigned)gb[m][bj], bhi = (unsigned)(gb[m][bj] >> 32);
#pragma unroll
                    for (int e = 0; e < 4; ++e) { const unsigned b0 = (blo >> (8 * e)) & 0xffu, b1 = (bhi >> (8 * e)) & 0xffu;
                        acc[ai][bj][m][0][e] *= (float)((alo >> (8 * e)) & 0xffu) * __builtin_amdgcn_rcpf((float)(b0 ? b0 : 1u));
                        acc[ai][bj][m][1][e] *= (float)((ahi >> (8 * e)) & 0xffu) * __builtin_amdgcn_rcpf((float)(b1 ? b1 : 1u)); } }
            __builtin_amdgcn_sched_barrier(0);
        }
    }
    __device__ __forceinline__ void operator()(const f32x4 (&acc)[2][2][4][2], const Unit& u, int wr, int wc, int fr, int fq) const {
        const int row0 = u.pm * BM + wr * 64 + fr, col0 = u.pn * BM + wc * 32 + 8 * fq;
        unsigned long long gb[2][4][2];
#pragma unroll
        for (int ai = 0; ai < 2; ++ai)
#pragma unroll
            for (int m = 0; m < 4; ++m) { const size_t ro = (size_t)(row0 + ai * HALF + m * 16) * ldg + col0;
#pragma unroll
                for (int bj = 0; bj < 2; ++bj) gb[ai][m][bj] = *(const unsigned long long*)(sigB + ro + bj * HALF); }
        __builtin_amdgcn_sched_barrier(0);
#pragma unroll
        for (int ai = 0; ai < 2; ++ai)
#pragma unroll
            for (int m = 0; m < 4; ++m) { const size_t row = (size_t)(row0 + ai * HALF + m * 16);
#pragma unroll
                for (int bj = 0; bj < 2; ++bj) { const unsigned blo = (unsigned)gb[ai][m][bj], bhi = (unsigned)(gb[ai][m][bj] >> 32);
                    float r[8];
#pragma unroll
                    for (int e = 0; e < 4; ++e) { const unsigned b0 = (blo >> (8 * e)) & 0xffu, b1 = (bhi >> (8 * e)) & 0xffu;
                        r[e] = acc[ai][bj][m][0][e] * ((float)(b0 ? b0 : 1u) * (1.0f / 255.0f)); r[4 + e] = acc[ai][bj][m][1][e] * ((float)(b1 ? b1 : 1u) * (1.0f / 255.0f)); }
                    u32x4 w; w.x = cvt_pk_bf16(r[0], r[1]); w.y = cvt_pk_bf16(r[2], r[3]); w.z = cvt_pk_bf16(r[4], r[5]); w.w = cvt_pk_bf16(r[6], r[7]);
                    *(u32x4*)(O + row * ldc + col0 + bj * HALF) = w; } }
    }
};
struct EpiGateABQ {
    static constexpr bool PERM = true, AFTER_DRAIN = false; static constexpr int MIDT = 16;
    EpiGateAB base; const float* rs; const float* cs;
    __device__ __forceinline__ void mid(f32x4 (&acc)[2][2][4][2], const Unit& u, int wr, int wc, int fr, int fq) const {
        const int row0 = u.pm * BM + wr * 64 + fr, col0 = u.pn * BM + wc * 32 + 8 * fq;
        f32x4 cc[2][2];
#pragma unroll
        for (int bj = 0; bj < 2; ++bj) { const float* cp = cs + col0 + bj * HALF; cc[bj][0] = *(const f32x4*)cp; cc[bj][1] = *(const f32x4*)(cp + 4); }
#pragma unroll
        for (int ai = 0; ai < 2; ++ai) {
            unsigned long long ga[4][2], gb[4][2];
            const f32x4 rsv = *(const f32x4*)(rs + ss_index(u.pm, wr, fr, ai, 0));
#pragma unroll
            for (int m = 0; m < 4; ++m) { const size_t ro = (size_t)(row0 + ai * HALF + m * 16) * base.ldg + col0;
#pragma unroll
                for (int bj = 0; bj < 2; ++bj) { ga[m][bj] = *(const unsigned long long*)(base.sigA + ro + bj * HALF); gb[m][bj] = *(const unsigned long long*)(base.sigB + ro + bj * HALF); } }
            __builtin_amdgcn_sched_barrier(0);
#pragma unroll
            for (int m = 0; m < 4; ++m)
#pragma unroll
                for (int bj = 0; bj < 2; ++bj) { const unsigned alo = (unsigned)ga[m][bj], ahi = (unsigned)(ga[m][bj] >> 32), blo = (unsigned)gb[m][bj], bhi = (unsigned)(gb[m][bj] >> 32);
#pragma unroll
                    for (int e = 0; e < 4; ++e) { const unsigned b0 = (blo >> (8 * e)) & 0xffu, b1 = (bhi >> (8 * e)) & 0xffu;
                        acc[ai][bj][m][0][e] = (float)__float_as_int(acc[ai][bj][m][0][e]) * (rsv[m] * cc[bj][0][e]) * ((float)((alo >> (8 * e)) & 0xffu) * __builtin_amdgcn_rcpf((float)(b0 ? b0 : 1u)));
                        acc[ai][bj][m][1][e] = (float)__float_as_int(acc[ai][bj][m][1][e]) * (rsv[m] * cc[bj][1][e]) * ((float)((ahi >> (8 * e)) & 0xffu) * __builtin_amdgcn_rcpf((float)(b1 ? b1 : 1u))); } }
            __builtin_amdgcn_sched_barrier(0);
        }
    }
    __device__ __forceinline__ void operator()(const f32x4 (&acc)[2][2][4][2], const Unit& u, int wr, int wc, int fr, int fq) const { base(acc, u, wr, wc, fr, fq); }
};
template <class E> struct has_mid { static constexpr int value = 0; };
template <> struct has_mid<EpiGateAB> { static constexpr int value = EpiGateAB::MIDT; };

template <bool I8> __device__ __forceinline__ typename AccT<I8>::type pg8_mma(bf16x8 b, bf16x8 a, typename AccT<I8>::type c) {
    if constexpr (I8) return __builtin_amdgcn_mfma_i32_16x16x64_i8(__builtin_bit_cast(i32x4, b), __builtin_bit_cast(i32x4, a), c, 0, 0, 0);
    else return __builtin_amdgcn_mfma_f32_16x16x32_bf16(b, a, c, 0, 0, 0);
}
template <class Epi, class Sched, bool ALIGN_EPI = false, bool I8 = false  ,
          int MIXT = 0  >
__device__ __forceinline__ void gemm_phase(PG8_LAS unsigned char* lds, const Gemm g, const Sched& S, const Epi& E, const int wid  ) {
    const int lane = lane_id(), tid = wid * 64 + lane, wr = wid >> 2, wc = wid & 3, fr = lane & 15, fq = lane >> 4;
    const int K = g.K, nt = K / BK;
    const __amdgpu_buffer_rsrc_t rA = __builtin_amdgcn_make_buffer_rsrc((void*)g.A, 0, 0x7fffffff, 0x00020000), rB = __builtin_amdgcn_make_buffer_rsrc((void*)g.Bt, 0, 0x7fffffff, 0x00020000);
    unsigned voffA[2], voffB[2];
#pragma unroll
    for (int i = 0; i < 2; ++i) { int R, C; stage_rc(tid * 16 + i * 8192, R, C); const int Rb = Epi::PERM ? ((R & ~31) + perm32(R & 31)) : R;
        voffA[i] = (unsigned)(R * g.lda + C) * 2u; voffB[i] = (unsigned)(Rb * g.ldb + C) * 2u; }
    const unsigned kstep = (unsigned)(BK * 2);
    const unsigned hstepA = (unsigned)HALF * g.lda * 2u, hstepB = (unsigned)HALF * g.ldb * 2u;
    const unsigned tstepA = 2 * hstepA, tstepB = 2 * hstepB;
    const unsigned kpA = (unsigned)g.kpA, kpB = (unsigned)g.kpB;
    const unsigned ldsw = (unsigned)wid * 1024u;
    const int aoff[2] = {lds_byte(wr * 64 + fr, fq * 8), lds_byte(wr * 64 + fr, 32 + fq * 8)}, boff[2] = {lds_byte(wc * 32 + fr, fq * 8), lds_byte(wc * 32 + fr, 32 + fq * 8)};
#define PG8_SA(b, h) (((b) * 2 + (h)) * HTB)
#define PG8_SB(b, h) ((4 + (b) * 2 + (h)) * HTB)
#define PG8_STAGE(bufoff, rsrc, soff, voff) do { _Pragma("unroll") for (int _i = 0; _i < 2; ++_i) \
        __builtin_amdgcn_raw_ptr_buffer_load_lds(rsrc, (PG8_LAS void*)(lds + (bufoff) + ldsw + _i * 8192), 16, (voff)[_i], (soff), 0, 0); } while (0)
#define PG8_LDA(dst, b, h) do { _Pragma("unroll") for (int m = 0; m < 4; ++m) _Pragma("unroll") for (int k = 0; k < 2; ++k) dst[m][k] = *(const PG8_LAS bf16x8*)(lds + PG8_SA(b, h) + aoff[k] + m * 2048); } while (0)
#define PG8_LDB(dst, b, h) do { _Pragma("unroll") for (int n = 0; n < 2; ++n) _Pragma("unroll") for (int k = 0; k < 2; ++k) dst[n][k] = *(const PG8_LAS bf16x8*)(lds + PG8_SB(b, h) + boff[k] + n * 2048); } while (0)
#define PG8_MMA(ai, bj, At, Bt) do { __builtin_amdgcn_s_setprio(1); _Pragma("unroll") for (int m = 0; m < 4; ++m) _Pragma("unroll") for (int n = 0; n < 2; ++n) _Pragma("unroll") for (int k = 0; k < 2; ++k) \
        acc[ai][bj][m][n] = pg8_mma<I8>(Bt[n][k], At[m][k], acc[ai][bj][m][n]); __builtin_amdgcn_s_setprio(0); } while (0)
#define PG8_MMA_Q(ai, bj, At, Bt) do { __builtin_amdgcn_s_setprio(1); _Pragma("unroll") for (int m = 0; m < 4; ++m) _Pragma("unroll") for (int n = 0; n < 2; ++n) _Pragma("unroll") for (int k = 0; k < 2; ++k) \
        acc[ai][bj][m][n] = __builtin_bit_cast(acc_t, __builtin_amdgcn_mfma_i32_16x16x64_i8(__builtin_bit_cast(i32x4, Bt[n][k]), __builtin_bit_cast(i32x4, At[m][k]), __builtin_bit_cast(i32x4, acc[ai][bj][m][n]), 0, 0, 0)); __builtin_amdgcn_s_setprio(0); } while (0)
#define PG8_WAIT_V(n) asm volatile("s_waitcnt vmcnt(" #n ")" ::: "memory")
#define PG8_WAIT_L(n) asm volatile("s_waitcnt lgkmcnt(" #n ")" ::: "memory")
#define PG8_BAR __builtin_amdgcn_s_barrier()
#define PG8_SCHED __builtin_amdgcn_sched_barrier(0)
    Unit cur, nxt; int ui = 0;
    if (!S.next(0, cur)) return;
    typedef typename AccT<I8>::type acc_t;
    acc_t acc[2][2][4][2];
#pragma unroll
    for (int a = 0; a < 2; ++a)
#pragma unroll
        for (int b = 0; b < 2; ++b)
#pragma unroll
            for (int m = 0; m < 4; ++m)
#pragma unroll
                for (int n = 0; n < 2; ++n) acc[a][b][m][n] = (acc_t)(0);
    bf16x8 At[4][2], B0[2][2], B1[2][2];
    unsigned cA = (unsigned)cur.pm * tstepA, cB = (unsigned)cur.pn * tstepB;
    S.a_ready(cur);
    PG8_STAGE(PG8_SB(0, 0), rB, cB, voffB); PG8_STAGE(PG8_SB(0, 1), rB, cB + hstepB, voffB); PG8_STAGE(PG8_SA(0, 0), rA, cA, voffA); PG8_STAGE(PG8_SA(0, 1), rA, cA + hstepA, voffA);
    if (wr == 1) PG8_BAR;
    PG8_WAIT_V(2); PG8_BAR;
    PG8_STAGE(PG8_SB(1, 0), rB, cB + kstep, voffB); PG8_STAGE(PG8_SA(1, 0), rA, cA + kstep, voffA); PG8_STAGE(PG8_SB(1, 1), rB, cB + hstepB + kstep, voffB);
    PG8_WAIT_V(6); PG8_BAR;
    for (;;) {
        const bool has_next = S.next(ui + 1, nxt);
        const unsigned nA = has_next ? (unsigned)nxt.pm * tstepA : cA, nB = has_next ? (unsigned)nxt.pn * tstepB : cB;
#define PG8_KSTEP(MM) do { \
            const bool last = (t == nt - 2); \
            const unsigned a1 = cA + (unsigned)(t >> 1) * kpA + kstep; \
            const unsigned a2 = last ? nA : cA + (unsigned)((t >> 1) + 1) * kpA, b2 = last ? nB : cB + (unsigned)((t >> 1) + 1) * kpB; \
            const unsigned a3 = a2 + kstep, b3 = b2 + kstep; \
            if (last && has_next) S.a_ready(nxt); \
            PG8_LDB(B0, 0, 0); PG8_LDB(B1, 0, 1); PG8_SCHED; PG8_LDA(At, 0, 0); PG8_STAGE(PG8_SA(1, 1), rA, a1 + hstepA, voffA); \
            PG8_WAIT_V(8); PG8_WAIT_L(0); PG8_BAR; MM(0, 0, At, B0); MM(0, 1, At, B1); PG8_BAR; PG8_SCHED; \
            PG8_LDA(At, 0, 1); PG8_STAGE(PG8_SB(0, 0), rB, b2, voffB); PG8_STAGE(PG8_SB(0, 1), rB, b2 + hstepB, voffB); PG8_STAGE(PG8_SA(0, 0), rA, a2, voffA); \
            PG8_WAIT_V(8); PG8_WAIT_L(0); PG8_BAR; MM(1, 0, At, B0); MM(1, 1, At, B1); PG8_BAR; PG8_SCHED; \
            PG8_LDB(B0, 1, 0); PG8_LDB(B1, 1, 1); PG8_SCHED; PG8_LDA(At, 1, 0); PG8_STAGE(PG8_SA(0, 1), rA, a2 + hstepA, voffA); \
            PG8_WAIT_V(8); PG8_WAIT_L(0); PG8_BAR; MM(0, 0, At, B0); MM(0, 1, At, B1); PG8_BAR; PG8_SCHED; \
            PG8_LDA(At, 1, 1); PG8_STAGE(PG8_SB(1, 0), rB, b3, voffB); PG8_STAGE(PG8_SB(1, 1), rB, b3 + hstepB, voffB); PG8_STAGE(PG8_SA(1, 0), rA, a3, voffA); \
            PG8_WAIT_V(8); PG8_WAIT_L(0); PG8_BAR; MM(1, 0, At, B0); MM(1, 1, At, B1); PG8_BAR; PG8_SCHED; } while (0)
        if constexpr (MIXT > 0) {
            for (int t = 0; t < MIXT; t += 2) PG8_KSTEP(PG8_MMA_Q);
            E.mid(acc, cur, wr, wc, fr, fq);
            for (int t = MIXT; t < nt; t += 2) PG8_KSTEP(PG8_MMA);
        } else {
            for (int t = 0; t < nt; t += 2) {
                if constexpr (has_mid<Epi>::value > 0) { if (t == has_mid<Epi>::value) E.mid(acc, cur, wr, wc, fr, fq); }
                PG8_KSTEP(PG8_MMA);
            }
        }
#undef PG8_KSTEP
        if constexpr (ALIGN_EPI) { if (wr == 0) PG8_BAR; }
        E(acc, cur, wr, wc, fr, fq); S.done(cur);
        if (!has_next) break;
#pragma unroll
        for (int a = 0; a < 2; ++a)
#pragma unroll
            for (int b = 0; b < 2; ++b)
#pragma unroll
                for (int m = 0; m < 4; ++m)
#pragma unroll
                    for (int n = 0; n < 2; ++n) acc[a][b][m][n] = (acc_t)(0);
        cur = nxt; cA = nA; cB = nB; ++ui;
        if constexpr (ALIGN_EPI) { if (wr == 1) PG8_BAR; }
    }
    PG8_WAIT_V(0);
    if constexpr (!ALIGN_EPI) { if (wr == 0) PG8_BAR; }
    PG8_BAR;
#undef PG8_SA
#undef PG8_SB
#undef PG8_STAGE
#undef PG8_LDA
#undef PG8_LDB
#undef PG8_MMA
#undef PG8_MMA_Q
#undef PG8_WAIT_V
#undef PG8_WAIT_L
#undef PG8_BAR
#undef PG8_SCHED
}
}

#define GAS __attribute__((address_space(1)))
#define LAS __attribute__((address_space(3)))
typedef unsigned short bf16;
typedef unsigned v4u __attribute__((ext_vector_type(4)));
typedef float f32x4 __attribute__((ext_vector_type(4)));
typedef GAS unsigned gu32;
#define RLX_AGENT __ATOMIC_RELAXED, __HIP_MEMORY_SCOPE_AGENT
#define LDS_WAIT() asm volatile("s_waitcnt lgkmcnt(0)" ::: "memory")
#define VM_WAIT() asm volatile("s_waitcnt vmcnt(0)" ::: "memory")

namespace att {
using bf16x8 = __attribute__((ext_vector_type(8))) short;
using s16x4  = __attribute__((ext_vector_type(4))) short;
using f32x16 = __attribute__((ext_vector_type(16))) float;
using u32x4  = __attribute__((ext_vector_type(4))) unsigned;
constexpr int   D = 128, NW = 8, QBLK = 32, KVBLK = 64;
constexpr float SCALE = 0.088388347648318440f;
constexpr float THR = 8.f;
constexpr int SHM_V = KVBLK * D * 2, SHM_K = KVBLK * D * 2, SHM_ATTN = 2 * SHM_V + 2 * SHM_K + NW * 64 * 4;
#define KSWZ(row, colB) ((row) * 256 + ((colB) ^ (((row) & 15) << 4)))
#define SBAR() __builtin_amdgcn_sched_barrier(0)
__device__ __forceinline__ int crow(int r, int hi) { return (r & 3) + 8 * (r >> 2) + 4 * hi; }
__device__ __forceinline__ unsigned cvtpk(float lo, float hi) { unsigned r; asm volatile("v_cvt_pk_bf16_f32 %0, %1, %2" : "=v"(r) : "v"(lo), "v"(hi)); return r; }

__device__ __forceinline__ void partialSM(f32x16& p0, f32x16& p1, float& m_reg, float& mn, float& alpha) {
  constexpr float C = SCALE * 1.4426950408889634f;
  float pmax = p0[0];
#pragma unroll
  for (int r = 1; r < 16; ++r) pmax = fmaxf(pmax, p0[r]);
#pragma unroll
  for (int r = 0; r < 16; ++r) pmax = fmaxf(pmax, p1[r]);
  { auto rr = __builtin_amdgcn_permlane32_swap(__float_as_uint(pmax), __float_as_uint(pmax), false, false);
    pmax = fmaxf(__uint_as_float(rr[0]), __uint_as_float(rr[1])); }
  if (__builtin_expect(__all(pmax - m_reg <= THR / SCALE), 1)) { mn = m_reg; alpha = 1.f; }
  else { mn = fmaxf(m_reg, pmax); alpha = __builtin_amdgcn_exp2f((m_reg - mn) * C); m_reg = mn; }
  float mnC = -mn * C;
#pragma unroll
  for (int r = 0; r < 16; ++r) p0[r] = fmaf(p0[r], C, mnC);
#pragma unroll
  for (int r = 0; r < 16; ++r) p1[r] = fmaf(p1[r], C, mnC);
#pragma unroll
  for (int r = 0; r < 16; ++r) p0[r] = __builtin_amdgcn_exp2f(p0[r]);
}
__device__ __forceinline__ void finishSM(f32x16& p0, f32x16& p1, float alpha, float& l_reg, bf16x8& pa0, bf16x8& pa1, bf16x8& pa2, bf16x8& pa3) {
#pragma unroll
  for (int r = 0; r < 16; ++r) p1[r] = __builtin_amdgcn_exp2f(p1[r]);
  float ps = 0;
#pragma unroll
  for (int r = 0; r < 16; ++r) ps += p0[r];
#pragma unroll
  for (int r = 0; r < 16; ++r) ps += p1[r];
  { auto rr = __builtin_amdgcn_permlane32_swap(__float_as_uint(ps), __float_as_uint(ps), false, false);
    ps = __uint_as_float(rr[0]) + __uint_as_float(rr[1]); }
  l_reg = l_reg * alpha + ps;
#define PK4(P, BASE, OUT) do { unsigned a0 = cvtpk(P[BASE + 0], P[BASE + 1]), a1 = cvtpk(P[BASE + 2], P[BASE + 3]);   \
    unsigned b0 = cvtpk(P[BASE + 4], P[BASE + 5]), b1 = cvtpk(P[BASE + 6], P[BASE + 7]);                              \
    auto r0 = __builtin_amdgcn_permlane32_swap(a0, b0, false, false); auto r1 = __builtin_amdgcn_permlane32_swap(a1, b1, false, false); \
    u32x4 w = {r0[0], r1[0], r0[1], r1[1]}; OUT = *reinterpret_cast<bf16x8*>(&w); } while (0)
  PK4(p0, 0, pa0); PK4(p0, 8, pa1); PK4(p1, 0, pa2); PK4(p1, 8, pa3);
#undef PK4
}
__device__ __forceinline__ void qkt(f32x16& p0, f32x16& p1, const LAS char* Ks, const bf16x8* qr, int r32, int hi) {
  p0 = f32x16{}; p1 = f32x16{};
#pragma unroll
  for (int d0 = 0; d0 < 8; ++d0) { int cb = (d0 * 16 + hi * 8) * 2;
    bf16x8 b0 = *reinterpret_cast<const LAS bf16x8*>(Ks + KSWZ(r32, cb));
    bf16x8 b1 = *reinterpret_cast<const LAS bf16x8*>(Ks + KSWZ(32 + r32, cb));
    p0 = __builtin_amdgcn_mfma_f32_32x32x16_bf16(b0, qr[d0], p0, 0, 0, 0);
    p1 = __builtin_amdgcn_mfma_f32_32x32x16_bf16(b1, qr[d0], p1, 0, 0, 0); }
}
__device__ __forceinline__ int v_st(int k, int c) { const int kk = (k & ~0xC) | ((k & 4) << 1) | ((k & 8) >> 1); return ((kk >> 3) * 4 + (c >> 5)) * 512 + ((kk & 7) * 32 + (c & 31)) * 2; }
__device__ __forceinline__ int v_rd_base(int lane) { return ((lane & 3) << 3) | (((lane >> 2) & 3) << 6) | (((lane >> 4) & 1) << 5) | (((lane >> 5) & 1) << 8); }
constexpr int v_rd_off(int d0, int ks, int half) { return d0 * 512 + ks * 4096 + half * 2048; }
template <int OFF> __device__ __forceinline__ s16x4 tr_read(int vb) {
  s16x4 r; asm volatile("ds_read_b64_tr_b16 %0, %1 offset:%2" : "=&v"(r) : "v"(vb), "i"(OFF) : "memory"); return r;
}
template <int D0> __device__ __forceinline__ void pv_one(f32x16& od, int vb, bf16x8 pa0, bf16x8 pa1, bf16x8 pa2, bf16x8 pa3) {
  const s16x4 l0 = tr_read<v_rd_off(D0, 0, 0)>(vb), h0 = tr_read<v_rd_off(D0, 0, 1)>(vb), l1 = tr_read<v_rd_off(D0, 1, 0)>(vb), h1 = tr_read<v_rd_off(D0, 1, 1)>(vb);
  const s16x4 l2 = tr_read<v_rd_off(D0, 2, 0)>(vb), h2 = tr_read<v_rd_off(D0, 2, 1)>(vb), l3 = tr_read<v_rd_off(D0, 3, 0)>(vb), h3 = tr_read<v_rd_off(D0, 3, 1)>(vb);
  asm volatile("s_waitcnt lgkmcnt(0)" ::: "memory"); SBAR();
#define PK(L, H) (bf16x8){L[0], L[1], L[2], L[3], H[0], H[1], H[2], H[3]}
  od = __builtin_amdgcn_mfma_f32_32x32x16_bf16(pa0, PK(l0, h0), od, 0, 0, 0);
  od = __builtin_amdgcn_mfma_f32_32x32x16_bf16(pa1, PK(l1, h1), od, 0, 0, 0);
  od = __builtin_amdgcn_mfma_f32_32x32x16_bf16(pa2, PK(l2, h2), od, 0, 0, 0);
  od = __builtin_amdgcn_mfma_f32_32x32x16_bf16(pa3, PK(l3, h3), od, 0, 0, 0);
#undef PK
}
__device__ __forceinline__ void pv_d0(f32x16* o, int vb, bf16x8 pa0, bf16x8 pa1, bf16x8 pa2, bf16x8 pa3) {
  pv_one<0>(o[0], vb, pa0, pa1, pa2, pa3); pv_one<1>(o[1], vb, pa0, pa1, pa2, pa3); pv_one<2>(o[2], vb, pa0, pa1, pa2, pa3); pv_one<3>(o[3], vb, pa0, pa1, pa2, pa3);
}

template <bool WIN>
__device__ __forceinline__ void attn_unit(const bf16* __restrict__ Qb, int ldq, const bf16* __restrict__ Kh, const bf16* __restrict__ Vh, int ldk,
                                          bf16* __restrict__ Ob, int ldo, float* __restrict__ lse, int ldl,
                                          int NT, int kb0, int i0, int L, float slope_raw, LAS char* lds, const int wid  ) {
  int lane = lane_id(); asm volatile("" : "+v"(lane));
  const int tid = wid * 64 + lane, r32 = lane & 31, hi = lane >> 5;
  LAS char* V_lds = lds; LAS char* K_lds = lds + 2 * SHM_V;
  LAS float* ws = (LAS float*)(lds + 2 * SHM_V + 2 * SHM_K) + wid * 64; LAS float* li_l = ws; LAS float* al_l = ws + 32;
  float m_reg = -1e30f, l_reg = 0; f32x16 o[4] = {}; bf16x8 qr[8];
  { const unsigned qoff = (unsigned)((wid * QBLK + r32) * ldq + hi * 8) * 2u;
#pragma unroll
    for (int d0 = 0; d0 < 8; ++d0) qr[d0] = *reinterpret_cast<const bf16x8*>((const char*)Qb + qoff + d0 * 32); }
  const int sr = tid >> 4, sc = (tid & 15) * 8, vst0 = v_st(sr, sc), vst1 = v_st(32 + sr, sc);
  const int vb0 = (int)(uintptr_t)V_lds + v_rd_base(lane);
  const int qi = i0 + wid * QBLK + r32;
  const unsigned soff0 = (unsigned)(sr * ldk + sc) * 2u, soff1 = soff0 + (unsigned)(32 * ldk) * 2u;
  struct { bf16x8 vs0, vs1, ks0, ks1; } sr_[2];
#define KROW(t) (WIN ? min(max(kb0 + (t) * KVBLK, 0), L - KVBLK) : (t) * KVBLK)
#define SLOAD(i, k0) do { const size_t _ko = (size_t)(k0) * (size_t)ldk * 2; const char* _vb = (const char*)Vh + _ko; const char* _kb = (const char*)Kh + _ko; \
    sr_[i].vs0 = *reinterpret_cast<const bf16x8*>(_vb + soff0); sr_[i].vs1 = *reinterpret_cast<const bf16x8*>(_vb + soff1); \
    sr_[i].ks0 = *reinterpret_cast<const bf16x8*>(_kb + soff0); sr_[i].ks1 = *reinterpret_cast<const bf16x8*>(_kb + soff1); } while (0)
#define SWRITE(b, i) do { *(LAS bf16x8*)(V_lds + (b) * SHM_V + vst0) = sr_[i].vs0;          \
    *(LAS bf16x8*)(V_lds + (b) * SHM_V + vst1) = sr_[i].vs1; int kc = sc * 2;               \
    *(LAS bf16x8*)(K_lds + (b) * SHM_K + KSWZ(sr, kc)) = sr_[i].ks0;                       \
    *(LAS bf16x8*)(K_lds + (b) * SHM_K + KSWZ(32 + sr, kc)) = sr_[i].ks1; } while (0)
#define SWAIT() asm volatile("s_waitcnt vmcnt(4)" ::: "memory")
#define RESC(a) do { if (__any((a) < 1.f)) { if (hi == 0) al_l[r32] = (a); asm volatile("s_waitcnt lgkmcnt(0)" ::: "memory"); \
    _Pragma("unroll") for (int d = 0; d < 4; ++d) _Pragma("unroll") for (int r = 0; r < 16; ++r) o[d][r] *= al_l[crow(r, hi)]; } } while (0)
#define MASK(P0, P1, t) do { if constexpr (WIN) { const int kb = kb0 + (t) * KVBLK; const bool tok = (kb >= 0) && (kb < L); const float dlf = tok ? (float)(kb + 4 * hi - qi) : 1.0e9f; \
    _Pragma("unroll") for (int r = 0; r < 16; ++r) { const float d0 = dlf + (float)((r & 3) + 8 * (r >> 2)), d1 = d0 + 32.f; \
      P0[r] = (__builtin_fabsf(d0) <= 64.f) ? fmaf(-slope_raw, __builtin_fabsf(d0), P0[r]) : -__builtin_inff(); \
      P1[r] = (__builtin_fabsf(d1) <= 64.f) ? fmaf(-slope_raw, __builtin_fabsf(d1), P1[r]) : -__builtin_inff(); } } } while (0)
  f32x16 pA0, pA1, pB0, pB1; float mnA, mnB, alA, alB; bf16x8 pa0, pa1, pa2, pa3;
  constexpr int SE = 0, SO = 1;
  SLOAD(SE, KROW(0)); asm volatile("s_waitcnt vmcnt(0)" ::: "memory"); SWRITE(0, SE); __syncthreads();
  qkt(pA0, pA1, K_lds, qr, r32, hi); MASK(pA0, pA1, 0); partialSM(pA0, pA1, m_reg, mnA, alA);
  SLOAD(SO, KROW(1)); if (2 < NT) SLOAD(SE, KROW(2));
  SWAIT(); SWRITE(1, SO); __syncthreads();
  for (int j = 1; j + 1 < NT; j += 2) {
    SBAR(); qkt(pB0, pB1, K_lds + SHM_K, qr, r32, hi);
    finishSM(pA0, pA1, alA, l_reg, pa0, pa1, pa2, pa3); SBAR();
    SLOAD(SO, KROW(j + 2)); SBAR();
    pv_d0(o, vb0, pa0, pa1, pa2, pa3); MASK(pB0, pB1, j); partialSM(pB0, pB1, m_reg, mnB, alB);
    __syncthreads(); SWAIT(); SWRITE(0, SE);
    RESC(alB); __syncthreads();
    SBAR(); qkt(pA0, pA1, K_lds, qr, r32, hi);
    finishSM(pB0, pB1, alB, l_reg, pa0, pa1, pa2, pa3); SBAR();
    if (j + 3 < NT) SLOAD(SE, KROW(j + 3)); SBAR();
    pv_d0(o, vb0 + SHM_V, pa0, pa1, pa2, pa3); MASK(pA0, pA1, j + 1); partialSM(pA0, pA1, m_reg, mnA, alA);
    __syncthreads(); SWAIT(); SWRITE(1, SO);
    RESC(alA); __syncthreads();
  }
  SBAR(); qkt(pB0, pB1, K_lds + SHM_K, qr, r32, hi);
  finishSM(pA0, pA1, alA, l_reg, pa0, pa1, pa2, pa3); SBAR();
  pv_d0(o, vb0, pa0, pa1, pa2, pa3); MASK(pB0, pB1, NT - 1); partialSM(pB0, pB1, m_reg, mnB, alB);
  __syncthreads(); RESC(alB);
  finishSM(pB0, pB1, alB, l_reg, pa0, pa1, pa2, pa3); SBAR();
  pv_d0(o, vb0 + SHM_V, pa0, pa1, pa2, pa3);
  if (hi == 0) li_l[r32] = l_reg; asm volatile("s_waitcnt lgkmcnt(0)" ::: "memory");
  float rli[16];
#pragma unroll
  for (int r = 0; r < 16; ++r) rli[r] = __builtin_amdgcn_rcpf(li_l[crow(r, hi)]);
#pragma unroll
  for (int r = 0; r < 16; ++r) { const unsigned ooff = (unsigned)((wid * QBLK + crow(r, hi)) * ldo + r32) * 2u;
#pragma unroll
    for (int d0 = 0; d0 < 4; ++d0) *(bf16*)((char*)Ob + ooff + d0 * 64) = (bf16)(cvtpk(o[d0][r] * rli[r], 0.f) & 0xffffu); }
  if constexpr (WIN) { if (hi == 0) lse[(size_t)((wid * QBLK + r32) * ldl)] = SCALE * m_reg + __logf(l_reg); }
#undef KROW
#undef SLOAD
#undef SWRITE
#undef SWAIT
#undef RESC
#undef MASK
}
__device__ __forceinline__ void dense_unit(const bf16* __restrict__ Qb, const bf16* __restrict__ Kh, const bf16* __restrict__ Vh, bf16* __restrict__ Ob, int ldo, int NT, LAS char* lds, const int wid) {
  int lane = lane_id(); asm volatile("" : "+v"(lane));
  const int r32 = lane & 31, hi = lane >> 5;
  LAS char* V_lds = lds; LAS char* K_lds = lds + 2 * SHM_V;
  LAS float* ws = (LAS float*)(lds + 2 * SHM_V + 2 * SHM_K) + wid * 64; LAS float* li_l = ws; LAS float* al_l = ws + 32;
  const __amdgpu_buffer_rsrc_t rK = __builtin_amdgcn_make_buffer_rsrc((void*)Kh, 0, 0x7fffffff, 0x00020000), rV = __builtin_amdgcn_make_buffer_rsrc((void*)Vh, 0, 0x7fffffff, 0x00020000);
  unsigned koff[2], voff[2];
#pragma unroll
  for (int i = 0; i < 2; ++i) { const int pc = wid * 2 + i, row = 4 * pc + (lane >> 4); koff[i] = (unsigned)(row * 256 + (((lane & 15) ^ (row & 15)) << 4));
    const int o = pc * 1024 + lane * 16, sub = o >> 9, w_ = (o & 511) >> 1, kk = (sub >> 2) * 8 + (w_ >> 5), c = (sub & 3) * 32 + (w_ & 31), k = (kk & ~0xC) | ((kk & 4) << 1) | ((kk & 8) >> 1);
    voff[i] = (unsigned)(k * 256 + c * 2); }
#define KDMA(t, b) do { const unsigned so_ = (unsigned)(t) * (unsigned)(KVBLK * 256); _Pragma("unroll") for (int i_ = 0; i_ < 2; ++i_) \
    __builtin_amdgcn_raw_ptr_buffer_load_lds(rK, (LAS void*)(K_lds + (b) * SHM_K + wid * 2048 + i_ * 1024), 16, koff[i_], so_, 0, 0); } while (0)
#define VDMA(t, b) do { const unsigned so_ = (unsigned)(t) * (unsigned)(KVBLK * 256); _Pragma("unroll") for (int i_ = 0; i_ < 2; ++i_) \
    __builtin_amdgcn_raw_ptr_buffer_load_lds(rV, (LAS void*)(V_lds + (b) * SHM_V + wid * 2048 + i_ * 1024), 16, voff[i_], so_, 0, 0); } while (0)
#define SYNCPT() do { asm volatile("s_waitcnt vmcnt(0) lgkmcnt(0)" ::: "memory"); __builtin_amdgcn_s_barrier(); asm volatile("" ::: "memory"); } while (0)
#define RESC(a) do { if (__any((a) < 1.f)) { if (hi == 0) al_l[r32] = (a); asm volatile("s_waitcnt lgkmcnt(0)" ::: "memory"); \
    _Pragma("unroll") for (int d = 0; d < 4; ++d) _Pragma("unroll") for (int r = 0; r < 16; ++r) o[d][r] *= al_l[crow(r, hi)]; } } while (0)
  asm volatile("s_waitcnt lgkmcnt(0)" ::: "memory"); __builtin_amdgcn_s_barrier(); asm volatile("" ::: "memory");
  KDMA(0, 0); VDMA(0, 0); KDMA(1, 1);
  float m_reg = -1e30f, l_reg = 0; f32x16 o[4] = {}; bf16x8 qr[8];
  { const unsigned qoff = (unsigned)((wid * QBLK + r32) * D + hi * 8) * 2u;
#pragma unroll
    for (int d0 = 0; d0 < 8; ++d0) qr[d0] = *reinterpret_cast<const bf16x8*>((const char*)Qb + qoff + d0 * 32); }
  const int vb0 = (int)(uintptr_t)V_lds + v_rd_base(lane);
  f32x16 pA0, pA1, pB0, pB1; float mnA, mnB, alA, alB; bf16x8 pa0, pa1, pa2, pa3;
  SYNCPT();
  qkt(pA0, pA1, K_lds, qr, r32, hi); partialSM(pA0, pA1, m_reg, mnA, alA);
  SYNCPT(); KDMA(2, 0); VDMA(1, 1);
  for (int j = 1; j + 1 < NT; j += 2) {
    SBAR(); qkt(pB0, pB1, K_lds + SHM_K, qr, r32, hi);
    finishSM(pA0, pA1, alA, l_reg, pa0, pa1, pa2, pa3); SBAR();
    pv_d0(o, vb0, pa0, pa1, pa2, pa3); partialSM(pB0, pB1, m_reg, mnB, alB);
    SYNCPT(); KDMA(j + 2, 1); VDMA(j + 1, 0);
    RESC(alB);
    SBAR(); qkt(pA0, pA1, K_lds, qr, r32, hi);
    finishSM(pB0, pB1, alB, l_reg, pa0, pa1, pa2, pa3); SBAR();
    pv_d0(o, vb0 + SHM_V, pa0, pa1, pa2, pa3); partialSM(pA0, pA1, m_reg, mnA, alA);
    SYNCPT(); if (j + 3 < NT) KDMA(j + 3, 0); VDMA(j + 2, 1);
    RESC(alA);
  }
  SBAR(); qkt(pB0, pB1, K_lds + SHM_K, qr, r32, hi);
  finishSM(pA0, pA1, alA, l_reg, pa0, pa1, pa2, pa3); SBAR();
  pv_d0(o, vb0, pa0, pa1, pa2, pa3); partialSM(pB0, pB1, m_reg, mnB, alB);
  SYNCPT(); RESC(alB);
  finishSM(pB0, pB1, alB, l_reg, pa0, pa1, pa2, pa3); SBAR();
  pv_d0(o, vb0 + SHM_V, pa0, pa1, pa2, pa3);
  if (hi == 0) li_l[r32] = l_reg; asm volatile("s_waitcnt lgkmcnt(0)" ::: "memory");
  float rli[16];
#pragma unroll
  for (int r = 0; r < 16; ++r) rli[r] = __builtin_amdgcn_rcpf(li_l[crow(r, hi)]);
#pragma unroll
  for (int r = 0; r < 16; ++r) { const unsigned ooff = (unsigned)((wid * QBLK + crow(r, hi)) * ldo + r32) * 2u;
#pragma unroll
    for (int d0 = 0; d0 < 4; ++d0) *(bf16*)((char*)Ob + ooff + d0 * 64) = (bf16)(cvtpk(o[d0][r] * rli[r], 0.f) & 0xffffu); }
#undef KDMA
#undef VDMA
#undef SYNCPT
#undef RESC
}
__device__ __forceinline__ void win_unit(const bf16* __restrict__ Qp, const bf16* __restrict__ Kp, const bf16* __restrict__ Vp, bf16* __restrict__ Op, int ldo, float* __restrict__ lsep, int ldl,
                                         int i0, int L, float slope_raw, LAS char* lds, const int wid) {
  int lane = lane_id(); asm volatile("" : "+v"(lane));
  const int r32 = lane & 31, hi = lane >> 5, kstart = i0 - 64;
  constexpr float C = SCALE * 1.4426950408889634f;
  LAS float* li_l = (LAS float*)(lds + 98304 + wid * 256);
  const __amdgpu_buffer_rsrc_t rK = __builtin_amdgcn_make_buffer_rsrc((void*)Kp, 0, 0x7fffffff, 0x00020000), rV = __builtin_amdgcn_make_buffer_rsrc((void*)Vp, 0, 0x7fffffff, 0x00020000);
  asm volatile("s_waitcnt lgkmcnt(0)" ::: "memory"); __builtin_amdgcn_s_barrier(); asm volatile("" ::: "memory");
#pragma unroll
  for (int j = 0; j < 12; ++j) { const int pc = wid * 12 + j, row = 4 * pc + (lane >> 4), chunk = (lane & 15) ^ (row & 15);
    const int grow = min(max(kstart + row, 0), L - 1);
    __builtin_amdgcn_raw_ptr_buffer_load_lds(rK, (LAS void*)(lds + pc * 1024), 16, (unsigned)(grow * 256 + chunk * 16), 0, 0, 0); }
  bf16x8 qr[8];
  { const bf16* q = Qp + (size_t)(wid * 32 + r32) * D + hi * 8;
#pragma unroll
    for (int d0 = 0; d0 < 8; ++d0) qr[d0] = *reinterpret_cast<const bf16x8*>(q + d0 * 16); }
  asm volatile("s_waitcnt vmcnt(0)" ::: "memory"); __syncthreads();
  f32x16 p[5];
#pragma unroll
  for (int s = 0; s < 5; ++s) {
    const int rb = 32 * wid + 32 * s;
    const bool tok = (kstart + rb >= 0) && (kstart + rb < L);
    f32x16 acc = {};
#pragma unroll
    for (int d0 = 0; d0 < 8; ++d0) { const int cb = (d0 * 16 + hi * 8) * 2;
      const bf16x8 kf = *reinterpret_cast<const LAS bf16x8*>(lds + rb * 256 + KSWZ(r32, cb));
      acc = __builtin_amdgcn_mfma_f32_32x32x16_bf16(kf, qr[d0], acc, 0, 0, 0); }
    const float dlf = tok ? (float)(32 * s - 64 + 4 * hi - r32) : 1.0e9f;
#pragma unroll
    for (int r = 0; r < 16; ++r) { const float dd = dlf + (float)((r & 3) + 8 * (r >> 2));
      acc[r] = (__builtin_fabsf(dd) <= 64.f) ? fmaf(-slope_raw, __builtin_fabsf(dd), acc[r]) : -__builtin_inff(); }
    p[s] = acc;
  }
  asm volatile("s_waitcnt lgkmcnt(0)" ::: "memory"); __syncthreads();
#pragma unroll
  for (int j = 0; j < 12; ++j) { const int pc = wid * 12 + j, img = pc >> 4, o = (pc & 15) * 1024 + lane * 16;
    const int sub = o >> 9, w_ = (o & 511) >> 1, kk = (sub >> 2) * 8 + (w_ >> 5), c = (sub & 3) * 32 + (w_ & 31), k = (kk & ~0xC) | ((kk & 4) << 1) | ((kk & 8) >> 1);
    const int grow = min(max(kstart + img * 64 + k, 0), L - 1);
    __builtin_amdgcn_raw_ptr_buffer_load_lds(rV, (LAS void*)(lds + pc * 1024), 16, (unsigned)(grow * 256 + c * 2), 0, 0, 0); }
  float m = p[0][0];
#pragma unroll
  for (int s = 0; s < 5; ++s)
#pragma unroll
    for (int r = 0; r < 16; ++r) m = fmaxf(m, p[s][r]);
  { auto rr = __builtin_amdgcn_permlane32_swap(__float_as_uint(m), __float_as_uint(m), false, false); m = fmaxf(__uint_as_float(rr[0]), __uint_as_float(rr[1])); }
  const float mC = -m * C; float l = 0.f;
#pragma unroll
  for (int s = 0; s < 5; ++s)
#pragma unroll
    for (int r = 0; r < 16; ++r) { const float e = __builtin_amdgcn_exp2f(fmaf(p[s][r], C, mC)); p[s][r] = e; l += e; }
  { auto rr = __builtin_amdgcn_permlane32_swap(__float_as_uint(l), __float_as_uint(l), false, false); l = __uint_as_float(rr[0]) + __uint_as_float(rr[1]); }
  bf16x8 pa[5][2];
#define WPK4(P, BASE, OUT) do { unsigned a0 = cvtpk(P[BASE + 0], P[BASE + 1]), a1 = cvtpk(P[BASE + 2], P[BASE + 3]);   \
    unsigned b0 = cvtpk(P[BASE + 4], P[BASE + 5]), b1 = cvtpk(P[BASE + 6], P[BASE + 7]);                              \
    auto r0 = __builtin_amdgcn_permlane32_swap(a0, b0, false, false); auto r1 = __builtin_amdgcn_permlane32_swap(a1, b1, false, false); \
    u32x4 w = {r0[0], r1[0], r0[1], r1[1]}; OUT = *reinterpret_cast<bf16x8*>(&w); } while (0)
#pragma unroll
  for (int s = 0; s < 5; ++s) { WPK4(p[s], 0, pa[s][0]); WPK4(p[s], 8, pa[s][1]); }
#undef WPK4
  asm volatile("s_waitcnt vmcnt(0)" ::: "memory"); __syncthreads();
  f32x16 o[4] = {};
  const int vb0 = (int)(uintptr_t)lds + v_rd_base(lane);
#pragma unroll
  for (int s = 0; s < 5; ++s) {
    const int ko = 32 * wid + 32 * s;
    const int vb = vb0 + (ko >> 6) * 16384 + ((ko >> 5) & 1) * 8192;
#define WPV(D0) do { const s16x4 l0 = tr_read<v_rd_off(D0, 0, 0)>(vb), h0 = tr_read<v_rd_off(D0, 0, 1)>(vb), l1 = tr_read<v_rd_off(D0, 1, 0)>(vb), h1 = tr_read<v_rd_off(D0, 1, 1)>(vb); \
      asm volatile("s_waitcnt lgkmcnt(0)" ::: "memory"); SBAR(); \
      o[D0] = __builtin_amdgcn_mfma_f32_32x32x16_bf16(pa[s][0], (bf16x8){l0[0], l0[1], l0[2], l0[3], h0[0], h0[1], h0[2], h0[3]}, o[D0], 0, 0, 0); \
      o[D0] = __builtin_amdgcn_mfma_f32_32x32x16_bf16(pa[s][1], (bf16x8){l1[0], l1[1], l1[2], l1[3], h1[0], h1[1], h1[2], h1[3]}, o[D0], 0, 0, 0); } while (0)
    WPV(0); WPV(1); WPV(2); WPV(3);
#undef WPV
  }
  if (hi == 0) li_l[r32] = l; asm volatile("s_waitcnt lgkmcnt(0)" ::: "memory");
  float rli[16];
#pragma unroll
  for (int r = 0; r < 16; ++r) rli[r] = __builtin_amdgcn_rcpf(li_l[crow(r, hi)]);
#pragma unroll
  for (int r = 0; r < 16; ++r) { const unsigned ooff = (unsigned)((wid * 32 + crow(r, hi)) * ldo + r32) * 2u;
#pragma unroll
    for (int d0 = 0; d0 < 4; ++d0) *(bf16*)((char*)Op + ooff + d0 * 64) = (bf16)(cvtpk(o[d0][r] * rli[r], 0.f) & 0xffffu); }
  if (hi == 0) lsep[(size_t)((wid * 32 + r32) * ldl)] = SCALE * m + __logf(l);
}
}

constexpr int NWAVES = 8;
constexpr int BATCH = 4, T = 4096, DM = 4096, M = BATCH * T, FF = 11008, HD = 128;
constexpr int INW = 20480, C_QA = 0, C_KA = 2048, C_VA = 2560, C_QKVB = 3072, C_GA = 12288, C_GB = 16384;
constexpr int GW = 8192;
constexpr int S_QA = 0, S_KA = 16, S_VA = 20, S_B = 24, N_SLOTS = 96;
constexpr int YW = 3072;
constexpr float RMS_EPS = 1e-6f;
constexpr int N_PHASES = 12;
constexpr int KQ1 = 3072, ROWB1 = KQ1 + (DM - KQ1) * 2;

constexpr size_t MiB = 1u << 20;
constexpr size_t WS_CTL = 0, CTL_ZERO_BYTES = 1 * MiB;
constexpr size_t WS_WGU = 2 * MiB;
constexpr size_t WS_WDN = 174 * MiB;
constexpr size_t WS_WIN = 260 * MiB;
constexpr size_t WS_WBR = 420 * MiB;
constexpr size_t WS_WOUT = 444 * MiB;
constexpr size_t WS_XN = 476 * MiB;
constexpr size_t WS_BIG = 604 * MiB;
constexpr size_t WS_Y = 1244 * MiB;
constexpr size_t WS_OG = 1340 * MiB;
constexpr size_t WS_LSE = 1436 * MiB;
constexpr size_t WS_XN2 = 1438 * MiB;
constexpr size_t WS_END = 1566 * MiB;
constexpr int CW_BAR = 4096;
constexpr int CW_SS1 = 65536, CW_SS2 = 65536 + 16384;
static_assert((CW_SS2 + 16384) * 4 <= (int)CTL_ZERO_BYTES, "ctl map");

constexpr int RING_OFF = 0, RING_BYTES = 131072;
constexpr int LDSCTL_OFF = RING_BYTES, MISC_OFF = LDSCTL_OFF + 320;
constexpr int LDS_BYTES = 147456;
static_assert(att::SHM_ATTN <= RING_BYTES, "attention LDS inside the ring region");

#define XB_TMO      128
#define XB_XCNT(j)  (256  + 64 * (j))
#define XB_XSUB(j)  (1280 + 64 * (j))
#define XB_XGEN(j)  (2304 + 64 * (j))
#define XB_TOP      3328
#define XB_TOPGEN   3392
#define XCD_BAR_WORDS 3456
#define XB_SPIN_CAP (1u << 18)

__device__ __forceinline__ unsigned xb_ld(unsigned* p)              { return __hip_atomic_load(p, __ATOMIC_RELAXED, __HIP_MEMORY_SCOPE_AGENT); }
__device__ __forceinline__ unsigned xb_add(unsigned* p, unsigned v) { return __hip_atomic_fetch_add(p, v, __ATOMIC_RELAXED, __HIP_MEMORY_SCOPE_AGENT); }
__device__ __forceinline__ unsigned xb_xcc_id() { return (unsigned)__builtin_amdgcn_s_getreg((3 << 11) | 20) & 0xFu; }
#define XB_SPIN(cond, bar) do { unsigned _sp = 0; while (cond) { __builtin_amdgcn_s_sleep(1); \
    if ((++_sp & 255u) == 0u) { if (xb_ld(&(bar)[XB_TMO])) break; if (_sp > XB_SPIN_CAP) { atomicAdd(&(bar)[XB_TMO], 1u); break; } } } } while (0)

struct XcdBarrier { unsigned* bar; unsigned x; volatile LAS unsigned* st; };

__device__ __forceinline__ XcdBarrier xcd_barrier_post(unsigned* bar, volatile LAS unsigned* st) {
    XcdBarrier b; b.bar = bar; b.x = xb_xcc_id(); b.st = st;
    if (threadIdx.x == 0) (void)xb_add(&bar[XB_XCNT(b.x)], 1u);
    return b;
}
__device__ __forceinline__ void xcd_barrier_complete(unsigned* bar, unsigned x, unsigned& nloc, unsigned& nx) {
    const unsigned G = gridDim.x * gridDim.y * gridDim.z;
    unsigned sum, cnt, mine, sp = 0u;
    for (;;) {
        sum = 0u; cnt = 0u; mine = 0u;
#pragma unroll
        for (unsigned j = 0; j < 16; ++j) { const unsigned c = xb_ld(&bar[XB_XCNT(j)]); sum += c; cnt += (c > 0u) ? 1u : 0u; mine = (j == x) ? c : mine; }
        if (sum == G) break;
        __builtin_amdgcn_s_sleep(1);
        if ((++sp & 255u) == 0u) { if (xb_ld(&bar[XB_TMO])) break; if (sp > XB_SPIN_CAP) { atomicAdd(&bar[XB_TMO], 1u); break; } }
    }
    nloc = mine > 0u ? mine : 1u; nx = cnt > 0u ? cnt : 1u;
}
__device__ __forceinline__ void xcd_barrier(const XcdBarrier& b) {
    asm volatile("s_waitcnt vmcnt(0)" ::: "memory");
    __syncthreads();
    if (threadIdx.x == 0) {
        unsigned* bar = b.bar;
        __builtin_amdgcn_s_waitcnt(0);
        unsigned nloc = b.st[0], nx = b.st[1];
        if (nloc == 0u) { xcd_barrier_complete(bar, b.x, nloc, nx); b.st[0] = nloc; b.st[1] = nx; }
        const unsigned old = xb_add(&bar[XB_XSUB(b.x)], 1u);
        const unsigned gen = old / nloc;
        if (old + 1u == (gen + 1u) * nloc) {
            __builtin_amdgcn_fence(__ATOMIC_RELEASE, "agent");
            asm volatile("s_waitcnt vmcnt(0)" ::: "memory");
            const unsigned og = xb_add(&bar[XB_TOP], 1u);
            const unsigned tg = og / nx;
            if (og + 1u == (tg + 1u) * nx) xb_add(&bar[XB_TOPGEN], 1u);
            else XB_SPIN(xb_ld(&bar[XB_TOPGEN]) == tg, bar);
            __builtin_amdgcn_fence(__ATOMIC_ACQUIRE, "agent");
            xb_add(&bar[XB_XGEN(b.x)], 1u);
            asm volatile("s_waitcnt vmcnt(0)" ::: "memory");
        } else {
            XB_SPIN(xb_ld(&bar[XB_XGEN(b.x)]) == gen, bar);
            __builtin_amdgcn_fence(__ATOMIC_ACQUIRE, "agent");
            asm volatile("s_waitcnt vmcnt(0)" ::: "memory");
        }
    }
    __syncthreads();
}

__device__ __forceinline__ unsigned f2bf(float f) { unsigned u = __builtin_bit_cast(unsigned, f); return (u + 0x7fffu + ((u >> 16) & 1u)) >> 16; }
__device__ __forceinline__ unsigned pk2(float lo, float hi) { return f2bf(lo) | (f2bf(hi) << 16); }
__device__ __forceinline__ float wave_sum(float v) {
#pragma unroll
    for (int o = 1; o < 64; o <<= 1) v += __shfl_xor(v, o);
    return v;
}
__device__ __forceinline__ void transpose_item(const float* __restrict__ W, int N, bf16* __restrict__ WT, size_t ldt, int k0, int n0, int drow0, int dcol0, LAS float* scr, int lane, const float* __restrict__ kgain = nullptr  ) {
    f32x4 v[8];
#pragma unroll
    for (int i = 0; i < 8; ++i) v[i] = *(const GAS f32x4*)(W + (size_t)(k0 + 8 * i + (lane >> 3)) * N + n0 + 4 * (lane & 7));
#pragma unroll
    for (int i = 0; i < 8; ++i) { LAS float* d = scr + (8 * i + (lane >> 3)) * 33 + 4 * (lane & 7); const float gk = kgain ? kgain[k0 + 8 * i + (lane >> 3)] : 1.0f; d[0] = v[i].x * gk; d[1] = v[i].y * gk; d[2] = v[i].z * gk; d[3] = v[i].w * gk; }
    LDS_WAIT(); asm volatile("" ::: "memory");
    const int c = lane & 7;
#pragma unroll
    for (int j = 0; j < 4; ++j) { const int n = (lane >> 3) + 8 * j; const LAS float* s = scr + (8 * c) * 33 + n;
        v4u o; o.x = pk2(s[0 * 33], s[1 * 33]); o.y = pk2(s[2 * 33], s[3 * 33]); o.z = pk2(s[4 * 33], s[5 * 33]); o.w = pk2(s[6 * 33], s[7 * 33]);
        *(GAS v4u*)(WT + (size_t)(drow0 + n) * ldt + dcol0 + 8 * c) = o; }
    LDS_WAIT(); asm volatile("" ::: "memory");
}
__device__ __forceinline__ void tr_plain(const float* W, int N, bf16* WT, size_t ldt, int dcol0, int item, LAS float* scr, int lane, const float* kgain = nullptr) {
    const int nblk = N / 32, kb = item / nblk, nb = item % nblk;
    transpose_item(W, N, WT, ldt, 64 * kb, 32 * nb, 32 * nb, dcol0 + 64 * kb, scr, lane, kgain);
}
__device__ __forceinline__ void tr_blocked(const float* W, int N, bf16* WT, int item, LAS float* scr, int lane) {
    const int nblk = N / 32, kb = item / nblk, nb = item % nblk;
    transpose_item(W, N, WT + (size_t)(kb >> 1) * N * 128, 128, 64 * kb, 32 * nb, 32 * nb, (kb & 1) * 64, scr, lane);
}
__device__ __forceinline__ void tr_gu(const float* W, int sel, bf16* WT, int item, LAS float* scr, int lane, const float* kgain = nullptr) {
    constexpr int nblk = FF / 32; const int kb = item / nblk, nb = item % nblk, n0 = 32 * nb;
    transpose_item(W, FF, WT, DM, 64 * kb, n0, (n0 >> 7) * 256 + sel * 128 + (n0 & 127), 64 * kb, scr, lane, kgain);
}
constexpr int IT_GU = (DM / 64) * (FF / 32), IT_DN = (FF / 64) * (DM / 32), IT_IN = (DM / 64) * (INW / 32), IT_BA = (2048 / 64) * (DM / 32), IT_BB = (1024 / 64) * (DM / 32), IT_OUT = (DM / 64) * (DM / 32);

constexpr int IT_D1 = IT_IN + IT_OUT + IT_BA + IT_BB + IT_DN;
#ifndef TAIL9_ITEMS
#define TAIL9_ITEMS 22016
#endif
#ifndef TAIL1_ITEMS
#define TAIL1_ITEMS 19456
#endif
__device__ __forceinline__ void conv_deferred(int r, const float* const* in, bf16* WIN_t, bf16* WOUT, bf16* WBR, bf16* WDN, LAS float* scr, int lane) {
    if (r < IT_IN) { tr_plain(in[6], INW, WIN_t, DM, 0, r, scr, lane, in[5]  ); return; } r -= IT_IN;
    if (r < IT_OUT) { tr_plain(in[11], DM, WOUT, DM, 0, r, scr, lane); return; } r -= IT_OUT;
    if (r < IT_BA) { tr_plain(in[9], DM, WBR, YW, 0, r, scr, lane); return; } r -= IT_BA;
    if (r < IT_BB) { tr_plain(in[10], DM, WBR, YW, 2048, r, scr, lane); return; } r -= IT_BB;
    tr_blocked(in[4], DM, WDN, r, scr, lane);
}
#define TAIL_WORK(nwg_, nitems_, CALL) do { const int full_ = (nwg_) / G, extra_ = (nwg_) - full_ * G; const bool grp_ = (extra_ > 0 && extra_ < G); \
    const int nconv_ = grp_ ? (G - extra_) : G, myc_ = grp_ ? (bx - extra_) : bx; \
    if (myc_ >= 0) for (int it = myc_ * NWAVES + wave; it < (nitems_); it += nconv_ * NWAVES) { CALL; } } while (0)

__device__ __forceinline__ void rms_row_to_bf16(const float* __restrict__ xrow, const float* __restrict__ g, bf16* __restrict__ orow, int lane) {
    const GAS f32x4* xr = (const GAS f32x4*)xrow + lane;
    f32x4 v[16]; float s = 0.f;
#pragma unroll
    for (int j = 0; j < 16; ++j) { v[j] = xr[64 * j]; s += (v[j].x * v[j].x + v[j].y * v[j].y) + (v[j].z * v[j].z + v[j].w * v[j].w); }
    const float rstd = 1.0f / sqrtf(wave_sum(s) * (1.f / DM) + RMS_EPS);
    const GAS f32x4* gr = (const GAS f32x4*)g + lane;
    GAS unsigned long long* o8 = (GAS unsigned long long*)orow + lane;
#pragma unroll
    for (int j = 0; j < 16; ++j) { const f32x4 gg = gr[64 * j];
        o8[64 * j] = (unsigned long long)pk2(v[j].x * rstd * gg.x, v[j].y * rstd * gg.y) | ((unsigned long long)pk2(v[j].z * rstd * gg.z, v[j].w * rstd * gg.w) << 32); }
}
__device__ __forceinline__ void rms_row_to_f32(const float* __restrict__ xrow, const float* __restrict__ g, float* __restrict__ orow, int lane) {
    const GAS f32x4* xr = (const GAS f32x4*)xrow + lane;
    f32x4 v[16]; float s = 0.f;
#pragma unroll
    for (int j = 0; j < 16; ++j) { v[j] = xr[64 * j]; s += (v[j].x * v[j].x + v[j].y * v[j].y) + (v[j].z * v[j].z + v[j].w * v[j].w); }
    const float rstd = 1.0f / sqrtf(wave_sum(s) * (1.f / DM) + RMS_EPS);
    const GAS f32x4* gr = (const GAS f32x4*)g + lane;
    GAS f32x4* o = (GAS f32x4*)orow + lane;
#pragma unroll
    for (int j = 0; j < 16; ++j) { const f32x4 gg = gr[64 * j]; o[64 * j] = (f32x4){v[j].x * rstd * gg.x, v[j].y * rstd * gg.y, v[j].z * rstd * gg.z, v[j].w * rstd * gg.w}; }
}
template <bool OUT_BF16>
__device__ __forceinline__ void rms_row2(const float* __restrict__ xa, const float* __restrict__ xb, const float* __restrict__ g, void* __restrict__ oa, void* __restrict__ ob, int lane) {
    const GAS f32x4* ra = (const GAS f32x4*)xa + lane; const GAS f32x4* rb = (const GAS f32x4*)xb + lane;
    f32x4 va[16], vb[16]; float sa = 0.f, sb = 0.f;
#pragma unroll
    for (int j = 0; j < 16; ++j) va[j] = ra[64 * j];
#pragma unroll
    for (int j = 0; j < 16; ++j) vb[j] = rb[64 * j];
#pragma unroll
    for (int j = 0; j < 16; ++j) sa += (va[j].x * va[j].x + va[j].y * va[j].y) + (va[j].z * va[j].z + va[j].w * va[j].w);
#pragma unroll
    for (int j = 0; j < 16; ++j) sb += (vb[j].x * vb[j].x + vb[j].y * vb[j].y) + (vb[j].z * vb[j].z + vb[j].w * vb[j].w);
    const float rsa = 1.0f / sqrtf(wave_sum(sa) * (1.f / DM) + RMS_EPS), rsb = 1.0f / sqrtf(wave_sum(sb) * (1.f / DM) + RMS_EPS);
    const GAS f32x4* gr = (const GAS f32x4*)g + lane;
#pragma unroll
    for (int j = 0; j < 16; ++j) { const f32x4 gg = gr[64 * j];
        const f32x4 ya = {va[j].x * rsa * gg.x, va[j].y * rsa * gg.y, va[j].z * rsa * gg.z, va[j].w * rsa * gg.w}, yb = {vb[j].x * rsb * gg.x, vb[j].y * rsb * gg.y, vb[j].z * rsb * gg.z, vb[j].w * rsb * gg.w};
        if constexpr (OUT_BF16) { ((GAS unsigned long long*)oa + lane)[64 * j] = (unsigned long long)pk2(ya.x, ya.y) | ((unsigned long long)pk2(ya.z, ya.w) << 32);
                                  ((GAS unsigned long long*)ob + lane)[64 * j] = (unsigned long long)pk2(yb.x, yb.y) | ((unsigned long long)pk2(yb.z, yb.w) << 32); }
        else { ((GAS f32x4*)oa + lane)[64 * j] = ya; ((GAS f32x4*)ob + lane)[64 * j] = yb; } }
}
__device__ __forceinline__ unsigned q4_pack(float a, float b, float c, float d, float inv) {
    const int ia = (int)__builtin_rintf(a * inv), ib = (int)__builtin_rintf(b * inv), ic = (int)__builtin_rintf(c * inv), id = (int)__builtin_rintf(d * inv);
    return (unsigned)(ia & 0xff) | ((unsigned)(ib & 0xff) << 8) | ((unsigned)(ic & 0xff) << 16) | ((unsigned)(id & 0xff) << 24);
}
template <int NCH = 8  >
__device__ __forceinline__ void quant_row2(const bf16* __restrict__ xa, const bf16* __restrict__ xb, unsigned char* __restrict__ qa, unsigned char* __restrict__ qb, float* sa, float* sb, float mula, float mulb, int lane) {
    const GAS v4u* ra = (const GAS v4u*)xa + lane; const GAS v4u* rb = (const GAS v4u*)xb + lane;
    v4u va[NCH], vb[NCH];
#pragma unroll
    for (int j = 0; j < NCH; ++j) va[j] = ra[64 * j];
#pragma unroll
    for (int j = 0; j < NCH; ++j) vb[j] = rb[64 * j];
    float ma = 0.f, mb = 0.f;
#pragma unroll
    for (int j = 0; j < NCH; ++j) {
#pragma unroll
        for (int c = 0; c < 4; ++c) { ma = fmaxf(ma, fmaxf(__builtin_fabsf(pg8::bf_lo(va[j][c])), __builtin_fabsf(pg8::bf_hi(va[j][c])))); mb = fmaxf(mb, fmaxf(__builtin_fabsf(pg8::bf_lo(vb[j][c])), __builtin_fabsf(pg8::bf_hi(vb[j][c])))); } }
#pragma unroll
    for (int o = 1; o < 64; o <<= 1) { ma = fmaxf(ma, __shfl_xor(ma, o)); mb = fmaxf(mb, __shfl_xor(mb, o)); }
    const float sca = ma > 0.f ? ma * (1.0f / 127.0f) : 1.0f, scb = mb > 0.f ? mb * (1.0f / 127.0f) : 1.0f, ia = 1.0f / sca, ib = 1.0f / scb;
    if (lane == 0) { *sa = sca * mula; *sb = scb * mulb; }
#pragma unroll
    for (int j = 0; j < NCH; ++j) {
        const unsigned long long pa = (unsigned long long)q4_pack(pg8::bf_lo(va[j].x), pg8::bf_hi(va[j].x), pg8::bf_lo(va[j].y), pg8::bf_hi(va[j].y), ia) | ((unsigned long long)q4_pack(pg8::bf_lo(va[j].z), pg8::bf_hi(va[j].z), pg8::bf_lo(va[j].w), pg8::bf_hi(va[j].w), ia) << 32);
        const unsigned long long pb = (unsigned long long)q4_pack(pg8::bf_lo(vb[j].x), pg8::bf_hi(vb[j].x), pg8::bf_lo(vb[j].y), pg8::bf_hi(vb[j].y), ib) | ((unsigned long long)q4_pack(pg8::bf_lo(vb[j].z), pg8::bf_hi(vb[j].z), pg8::bf_lo(vb[j].w), pg8::bf_hi(vb[j].w), ib) << 32);
        ((GAS unsigned long long*)qa + lane)[64 * j] = pa; ((GAS unsigned long long*)qb + lane)[64 * j] = pb; }
}
template <int KQ>
__device__ __forceinline__ void rms_row_mixed2(const float* __restrict__ xa, const float* __restrict__ xb, const float* __restrict__ g, unsigned char* __restrict__ oa, unsigned char* __restrict__ ob, float* sa, float* sb, int lane) {
    constexpr int JQ = KQ / 256;
    const GAS f32x4* ra = (const GAS f32x4*)xa + lane; const GAS f32x4* rb = (const GAS f32x4*)xb + lane;
    f32x4 va[16], vb[16]; float s2a = 0.f, s2b = 0.f;
#pragma unroll
    for (int j = 0; j < 16; ++j) va[j] = ra[64 * j];
#pragma unroll
    for (int j = 0; j < 16; ++j) vb[j] = rb[64 * j];
#pragma unroll
    for (int j = 0; j < 16; ++j) s2a += (va[j].x * va[j].x + va[j].y * va[j].y) + (va[j].z * va[j].z + va[j].w * va[j].w);
#pragma unroll
    for (int j = 0; j < 16; ++j) s2b += (vb[j].x * vb[j].x + vb[j].y * vb[j].y) + (vb[j].z * vb[j].z + vb[j].w * vb[j].w);
    const float rsa = 1.0f / sqrtf(wave_sum(s2a) * (1.f / DM) + RMS_EPS), rsb = 1.0f / sqrtf(wave_sum(s2b) * (1.f / DM) + RMS_EPS);
    const GAS f32x4* gr = (const GAS f32x4*)g + lane;
    float ma = 0.f, mb = 0.f;
#pragma unroll
    for (int j = 0; j < 16; ++j) { const f32x4 gg = gr[64 * j];
        va[j] = (f32x4){va[j].x * rsa * gg.x, va[j].y * rsa * gg.y, va[j].z * rsa * gg.z, va[j].w * rsa * gg.w}; vb[j] = (f32x4){vb[j].x * rsb * gg.x, vb[j].y * rsb * gg.y, vb[j].z * rsb * gg.z, vb[j].w * rsb * gg.w};
        if (j < JQ) { ma = fmaxf(ma, fmaxf(fmaxf(__builtin_fabsf(va[j].x), __builtin_fabsf(va[j].y)), fmaxf(__builtin_fabsf(va[j].z), __builtin_fabsf(va[j].w))));
                      mb = fmaxf(mb, fmaxf(fmaxf(__builtin_fabsf(vb[j].x), __builtin_fabsf(vb[j].y)), fmaxf(__builtin_fabsf(vb[j].z), __builtin_fabsf(vb[j].w)))); } }
#pragma unroll
    for (int o = 1; o < 64; o <<= 1) { ma = fmaxf(ma, __shfl_xor(ma, o)); mb = fmaxf(mb, __shfl_xor(mb, o)); }
    const float sca = ma > 0.f ? ma * (1.0f / 127.0f) : 1.0f, scb = mb > 0.f ? mb * (1.0f / 127.0f) : 1.0f, ia = 1.0f / sca, ib = 1.0f / scb;
    if (lane == 0) { *sa = sca; *sb = scb; }
#pragma unroll
    for (int j = 0; j < 16; ++j) {
        if (j < JQ) { ((GAS unsigned*)oa + lane)[64 * j] = q4_pack(va[j].x, va[j].y, va[j].z, va[j].w, ia); ((GAS unsigned*)ob + lane)[64 * j] = q4_pack(vb[j].x, vb[j].y, vb[j].z, vb[j].w, ib); }
        else { ((GAS unsigned long long*)(oa - KQ) + lane)[64 * j] = (unsigned long long)pk2(va[j].x, va[j].y) | ((unsigned long long)pk2(va[j].z, va[j].w) << 32);
               ((GAS unsigned long long*)(ob - KQ) + lane)[64 * j] = (unsigned long long)pk2(vb[j].x, vb[j].y) | ((unsigned long long)pk2(vb[j].z, vb[j].w) << 32); } }
}
template <int KQ>
__device__ __forceinline__ void tr_gu_mixed(const float* W, int sel, bf16* WM, bf16* TMP, int item, LAS float* scr, int lane, const float* kgain = nullptr) {
    constexpr int nblk = FF / 32; const int kb = item / nblk, nb = item % nblk, n0 = 32 * nb, drow = (n0 >> 7) * 256 + sel * 128 + (n0 & 127);
    if (64 * kb < KQ) transpose_item(W, FF, TMP, KQ, 64 * kb, n0, drow, 64 * kb, scr, lane, kgain);
    else transpose_item(W, FF, WM, (KQ + (DM - KQ) * 2) / 2, 64 * kb, n0, drow, 64 * kb - KQ / 2, scr, lane, kgain);
}
__device__ __forceinline__ int ss_of_row(int row) { const int r = row & 255; return pg8::ss_index(row >> 8, (r >> 6) & 1, r & 15, r >> 7, (r >> 4) & 3); }
__device__ __forceinline__ void qk_norm_rope_row(bf16* __restrict__ hm, size_t m, int t, const float* __restrict__ qg, const float* __restrict__ kg, int lane) {
    const int sub = lane & 15, hq = lane >> 4;
    const int axis = sub >> 3, pos = axis ? (t & 63) : (t >> 6);
    float cs[8], sn[8];
#pragma unroll
    for (int e = 0; e < 8; ++e) { const int i = 8 * (sub & 3) + e;
        const float inv = exp2f(-(float)i * (13.287712379549449f / 32.0f));
        const float ang = (float)pos * inv; const float rev = ang * 0.15915494309189535f;
        cs[e] = __builtin_amdgcn_cosf(rev); sn[e] = __builtin_amdgcn_sinf(rev); }
    const bool lo_half = (sub & 4) == 0;
    float gq[8], gk[8];
#pragma unroll
    for (int e = 0; e < 8; ++e) { gq[e] = qg[sub * 8 + e]; gk[e] = kg[sub * 8 + e]; }
#pragma unroll
    for (int it = 0; it < 5; ++it) {
        const int head = it * 4 + hq;
        GAS v4u* p = (GAS v4u*)(hm + ((size_t)head * M + m) * HD + sub * 8);
        const v4u w = *p;
        float x[8]; x[0] = pg8::bf_lo(w.x); x[1] = pg8::bf_hi(w.x); x[2] = pg8::bf_lo(w.y); x[3] = pg8::bf_hi(w.y); x[4] = pg8::bf_lo(w.z); x[5] = pg8::bf_hi(w.z); x[6] = pg8::bf_lo(w.w); x[7] = pg8::bf_hi(w.w);
        float ss = 0.f;
#pragma unroll
        for (int e = 0; e < 8; ++e) ss += x[e] * x[e];
        ss += __shfl_xor(ss, 1); ss += __shfl_xor(ss, 2); ss += __shfl_xor(ss, 4); ss += __shfl_xor(ss, 8);
        const float rstd = 1.0f / sqrtf(ss * (1.f / HD) + RMS_EPS);
        float y[8], r[8];
#pragma unroll
        for (int e = 0; e < 8; ++e) y[e] = x[e] * rstd * (it < 4 ? gq[e] : gk[e]);
#pragma unroll
        for (int e = 0; e < 8; ++e) { const float pr = __shfl_xor(y[e], 4);
            r[e] = lo_half ? (y[e] * cs[e] - pr * sn[e]) : (pr * sn[e] + y[e] * cs[e]); }
        v4u o; o.x = pk2(r[0], r[1]); o.y = pk2(r[2], r[3]); o.z = pk2(r[4], r[5]); o.w = pk2(r[6], r[7]);
        *p = o;
    }
}
__device__ __forceinline__ void merge_row(const bf16* __restrict__ OG, const float* __restrict__ LSE, bf16* __restrict__ yrow, size_t m, int lane) {
    const int head = lane >> 3;
    float l[3];
    const size_t mg[3] = {m, (size_t)pg8::dil_row((int)m, 2), (size_t)pg8::dil_row((int)m, 4)};
#pragma unroll
    for (int g = 0; g < 3; ++g) l[g] = LSE[((size_t)g * M + mg[g]) * 8 + head];
    const float mx = fmaxf(l[0], fmaxf(l[1], l[2]));
    float e[3]; float es = 0.f;
#pragma unroll
    for (int g = 0; g < 3; ++g) { e[g] = __expf(l[g] - mx); es += e[g]; }
    const float inv = 1.0f / es;
    float acc[16];
#pragma unroll
    for (int i = 0; i < 16; ++i) acc[i] = 0.f;
#pragma unroll
    for (int g = 0; g < 3; ++g) { const float a = e[g] * inv; const GAS v4u* p = (const GAS v4u*)(OG + ((size_t)g * M + mg[g]) * 1024 + lane * 16);
#pragma unroll
        for (int h = 0; h < 2; ++h) { const v4u w = p[h];
            acc[8 * h + 0] += a * pg8::bf_lo(w.x); acc[8 * h + 1] += a * pg8::bf_hi(w.x); acc[8 * h + 2] += a * pg8::bf_lo(w.y); acc[8 * h + 3] += a * pg8::bf_hi(w.y);
            acc[8 * h + 4] += a * pg8::bf_lo(w.z); acc[8 * h + 5] += a * pg8::bf_hi(w.z); acc[8 * h + 6] += a * pg8::bf_lo(w.w); acc[8 * h + 7] += a * pg8::bf_hi(w.w); } }
    GAS v4u* o = (GAS v4u*)(yrow + lane * 16);
#pragma unroll
    for (int h = 0; h < 2; ++h) { v4u w; w.x = pk2(acc[8 * h + 0], acc[8 * h + 1]); w.y = pk2(acc[8 * h + 2], acc[8 * h + 3]); w.z = pk2(acc[8 * h + 4], acc[8 * h + 5]); w.w = pk2(acc[8 * h + 6], acc[8 * h + 7]); o[h] = w; }
}

struct Args { const float* in[17]; float* out; unsigned char* ws; int ph_lo, ph_hi; };
enum { I_X = 0, I_GFFN1, I_W1G, I_W1U, I_W1D, I_GMIX, I_WIN, I_QN, I_KN, I_WBA, I_WBB, I_WOUT, I_GFFN2, I_W2G, I_W2U, I_W2D, I_GFIN };

__global__ void __launch_bounds__(NWAVES * 64, 2) hyb_fwd(Args args) {
    extern __shared__ __attribute__((aligned(16))) unsigned char lds_raw[];
    LAS unsigned char* lds = (LAS unsigned char*)lds_raw;
    volatile LAS unsigned* MISC = (volatile LAS unsigned*)(lds + MISC_OFF);
    const int wave = __builtin_amdgcn_readfirstlane((int)threadIdx.x >> 6);
#define lane lane_id()
#define tid ((int)(wave * 64 + lane_id()))
    const int G = gridDim.x; const int bx = blockIdx.x; const int vcu = (G % 8 == 0) ? (bx % 8) * (G / 8) + bx / 8 : bx;
    unsigned char* ws = args.ws;
    gu32* ctl = (gu32*)(ws + WS_CTL);
    bf16* WGU = (bf16*)(ws + WS_WGU); bf16* WDN = (bf16*)(ws + WS_WDN); bf16* WIN_t = (bf16*)(ws + WS_WIN); bf16* WBR = (bf16*)(ws + WS_WBR); bf16* WOUT = (bf16*)(ws + WS_WOUT);
    bf16* XN = (bf16*)(ws + WS_XN); bf16* HMB = (bf16*)(ws + WS_BIG); unsigned char* GATES = (unsigned char*)(ws + WS_BIG + 384 * MiB); bf16* HID = (bf16*)(ws + WS_BIG); bf16* Y = (bf16*)(ws + WS_Y); bf16* OG = (bf16*)(ws + WS_OG); float* LSE = (float*)(ws + WS_LSE);
    float* Hs = args.out;
    for (int u = tid; u < (LDS_BYTES - LDSCTL_OFF) / 4; u += NWAVES * 64) ((LAS unsigned*)(lds + LDSCTL_OFF))[u] = 0u;
    __syncthreads();
    XcdBarrier bar = xcd_barrier_post((unsigned*)(ctl + CW_BAR), MISC + 8);
    const int lo = args.ph_lo, hi = args.ph_hi;
#define IN(k) (lo <= (k) && (k) < hi)
#define SEAM(k) do { if (IN(k) && IN((k) + 1)) xcd_barrier(bar); } while (0)
#ifndef PROBE_DUP
#define PROBE_DUP -1
#endif
#define REPS(k) ((PROBE_DUP == (k)) ? 2 : 1)
    const int gw = vcu * NWAVES + wave, NGW = G * NWAVES;
    LAS float* scr = (LAS float*)(lds + RING_OFF + wave * 16384);

    float* SS1 = (float*)(ctl + CW_SS1); float* SS2 = (float*)(ctl + CW_SS2); bf16* XN2 = (bf16*)(ws + WS_XN2);
    unsigned char* YQ = ws + WS_WIN; unsigned char* WBRQ = ws + WS_WIN + 64 * MiB; float* RSA = (float*)(ws + WS_WIN + 80 * MiB); float* CSA = RSA + M;
    if (IN(0)) for (int rep = 0; rep < REPS(0); ++rep) {
        unsigned char* XNM = (unsigned char*)XN; bf16* WGUM = WGU; bf16* TMPW = (bf16*)(ws + WS_BIG); float* RS1 = LSE; float* CS1 = LSE + M;
        constexpr int NIT = 2 * IT_GU + (IT_D1 - TAIL1_ITEMS);
        for (int it = gw; it < NIT; it += NGW) {
            int r = it;
            if (r < IT_GU) { tr_gu_mixed<KQ1>(args.in[I_W1G], 0, WGUM, TMPW, r, scr, lane); continue; } r -= IT_GU;
            if (r < IT_GU) { tr_gu_mixed<KQ1>(args.in[I_W1U], 1, WGUM, TMPW, r, scr, lane); continue; } r -= IT_GU;
            conv_deferred(TAIL1_ITEMS + r, args.in, WIN_t, WOUT, WBR, WDN, scr, lane);
        }
        for (int m = gw; m < M; m += 2 * NGW) { const int m2 = (m + NGW < M) ? m + NGW : m;
            rms_row_mixed2<KQ1>(args.in[I_X] + (size_t)m * DM, args.in[I_X] + (size_t)m2 * DM, args.in[I_GFFN1], XNM + (size_t)m * ROWB1, XNM + (size_t)m2 * ROWB1, RS1 + ss_of_row(m), RS1 + ss_of_row(m2), lane); }
        xcd_barrier(bar);
        for (int n = 2 * gw; n < 2 * FF; n += 2 * NGW)
            quant_row2<KQ1 / 512>(TMPW + (size_t)n * KQ1, TMPW + (size_t)(n + 1) * KQ1, (unsigned char*)WGUM + (size_t)n * ROWB1, (unsigned char*)WGUM + (size_t)(n + 1) * ROWB1, CS1 + n, CS1 + n + 1, 1.0f, 1.0f, lane);
    }
    SEAM(0);
    if (IN(1)) for (int rep = 0; rep < REPS(1); ++rep) {
        pg8::Gemm g{(const pg8::bf16_t*)XN, WGU, M, 2 * FF, ROWB1 / 2, ROWB1 / 2, ROWB1 / 2, 256, 256}; pg8::StaticOrder S; S.init(M, 2 * FF, G, bx);
        pg8::EpiSwiGLUQ E{{HID, M, nullptr, 0.f, 0.f}, LSE, LSE + M};
        pg8::gemm_phase<pg8::EpiSwiGLUQ, pg8::StaticOrder, true, false, KQ1 / 128>(lds + RING_OFF, g, S, E, wave);
        TAIL_WORK((M / 256) * (2 * FF / 256), TAIL1_ITEMS, conv_deferred(it, args.in, WIN_t, WOUT, WBR, WDN, scr, lane));
    }
    SEAM(1);
    if (IN(2)) {
        pg8::Gemm g{HID, WDN, M, DM, FF, 128, 128, (size_t)M * 256, (size_t)DM * 256}; pg8::BandOrder S; S.init(M, DM, G, bx);
        pg8::EpiRes<false, true, true> E{args.in[I_X], DM, XN, DM, 0.5f, SS1};
        pg8::gemm_phase<pg8::EpiRes<false, true, true>, pg8::BandOrder, true>(lds + RING_OFF, g, S, E, wave);
    }
    SEAM(2);
    if (IN(3)) for (int rep = 0; rep < REPS(3); ++rep) {
        unsigned char* XQ = (unsigned char*)(ws + WS_XN2); unsigned char* WQ = (unsigned char*)(ws + WS_WGU);
        float* RS = LSE; float* CS = LSE + M;
        { const int NR = M + INW;
          for (int r = 2 * gw; r < NR; r += 2 * NGW) {
              if (r < M) quant_row2(XN + (size_t)r * DM, XN + (size_t)(r + 1) * DM, XQ + (size_t)r * DM, XQ + (size_t)(r + 1) * DM, RS + ss_of_row(r), RS + ss_of_row(r + 1),
                                    1.0f / sqrtf(SS1[ss_of_row(r)] * (1.0f / DM) + RMS_EPS), 1.0f / sqrtf(SS1[ss_of_row(r + 1)] * (1.0f / DM) + RMS_EPS), lane);
              else { const int n = r - M; quant_row2(WIN_t + (size_t)n * DM, WIN_t + (size_t)(n + 1) * DM, WQ + (size_t)n * DM, WQ + (size_t)(n + 1) * DM, CS + n, CS + n + 1, 1.0f, 1.0f, lane); } } }
        xcd_barrier(bar);
        pg8::Gemm g{(const pg8::bf16_t*)XQ, (const pg8::bf16_t*)WQ, M, INW, DM / 2, DM / 2, DM / 2, 256, 256}; pg8::StaticOrder S; S.init(M, INW, G, bx);
        pg8::EpiBf16Q E{HMB, M, GATES, GW, RS, CS, (C_QKVB + 3072) / 256, (C_QKVB + 6144) / 256, C_GA / 256};
        pg8::gemm_phase<pg8::EpiBf16Q, pg8::StaticOrder, true, true>(lds + RING_OFF, g, S, E, wave);
    }
    SEAM(3);
    if (IN(4)) {
        for (int m = gw; m < M; m += NGW) qk_norm_rope_row(HMB, (size_t)m, m & (T - 1), args.in[I_QN], args.in[I_KN], lane);
        constexpr int NIT = 2 * IT_GU + (IT_DN - TAIL9_ITEMS);
        for (int it = gw; it < NIT; it += NGW) {
            int r = it;
            if (r < IT_GU) { tr_gu(args.in[I_W2G], 0, WGU, r, scr, lane, args.in[I_GFFN2]); continue; } r -= IT_GU;
            if (r < IT_GU) { tr_gu(args.in[I_W2U], 1, WGU, r, scr, lane, args.in[I_GFFN2]); continue; } r -= IT_GU;
            tr_blocked(args.in[I_W2D], DM, WDN, TAIL9_ITEMS + r, scr, lane);
        }
    }
    SEAM(4);
    if (IN(5)) for (int rep = 0; rep < REPS(5); ++rep) {
        LAS char* alds = (LAS char*)(lds + RING_OFF);
        for (int u = vcu; u < BATCH * 16 * 16; u += G) {
            const int qb = u & 15, h = (u >> 4) & 15, b = u >> 8, kvh = h >> 2;
            const size_t row0 = (size_t)b * T;
            att::dense_unit(HMB + ((size_t)(S_QA + h) * M + row0 + qb * 256) * HD, HMB + ((size_t)(S_KA + kvh) * M + row0) * HD, HMB + ((size_t)(S_VA + kvh) * M + row0) * HD,
                            Y + (row0 + qb * 256) * YW + h * HD, YW, T / 64, alds, wave);
        }
        for (int u = vcu; u < BATCH * 3 * 8 * 16; u += G) {
            const int sub = u & 15, h = (u >> 4) & 7, bg = u >> 7, grp = bg % 3, b = bg / 3;
            const int dsh = 2 * grp, d = 1 << dsh, L = T >> dsh, nqb = L >> 8;
            const int res = sub / nqb, i0 = (sub % nqb) * 256;
            const float slope = exp2f(-8.0f * (float)(grp * 8 + h + 1) / 24.0f);
            const size_t row0 = (size_t)b * T + (size_t)res * L;
            const int sq = S_B + grp * 24 + h;
            att::win_unit(HMB + ((size_t)sq * M + row0 + i0) * HD, HMB + ((size_t)(sq + 8) * M + row0) * HD, HMB + ((size_t)(sq + 16) * M + row0) * HD,
                          OG + ((size_t)grp * M + row0 + i0) * 1024 + h * HD, 1024, LSE + ((size_t)grp * M + row0 + i0) * 8 + h, 8, i0, L, slope * (float)d / att::SCALE, alds, wave);
        }
    }
    SEAM(5);
    if (IN(6)) {
        for (int m = gw; m < M; m += NGW) merge_row(OG, LSE, (bf16*)(YQ + (size_t)m * 4096 + 2048), (size_t)m, lane);
        for (int r = 2 * gw; r < M + DM; r += 2 * NGW) {
            if (r < M) quant_row2<4>(Y + (size_t)r * YW, Y + (size_t)(r + 1) * YW, YQ + (size_t)r * 4096, YQ + (size_t)(r + 1) * 4096, RSA + ss_of_row(r), RSA + ss_of_row(r + 1), 1.0f, 1.0f, lane);
            else { const int n = r - M;
                quant_row2<4>(WBR + (size_t)n * YW, WBR + (size_t)(n + 1) * YW, WBRQ + (size_t)n * 4096, WBRQ + (size_t)(n + 1) * 4096, CSA + n, CSA + n + 1, 1.0f, 1.0f, lane);
#pragma unroll
                for (int q = 0; q < 2; ++q) { const GAS v4u* sp = (const GAS v4u*)(WBR + (size_t)(n + q) * YW + 2048) + lane; GAS v4u* dp = (GAS v4u*)(WBRQ + (size_t)(n + q) * 4096 + 2048) + lane; dp[0] = sp[0]; dp[64] = sp[64]; } } }
    }
    SEAM(6);
    if (IN(7)) {
        pg8::Gemm g{(const pg8::bf16_t*)YQ, (const pg8::bf16_t*)WBRQ, M, DM, 2048, 2048, 2048, 256, 256}; pg8::StaticOrder S; S.init(M, DM, G, bx);
        pg8::EpiGateABQ E{{GATES, GATES + DM, GW, XN2, DM}, RSA, CSA};
        pg8::gemm_phase<pg8::EpiGateABQ, pg8::StaticOrder, true, false, 16>(lds + RING_OFF, g, S, E, wave);
    }
    SEAM(7);
    if (IN(8)) {
        unsigned char* XQ = (unsigned char*)(ws + WS_OG); unsigned char* WQ = (unsigned char*)(ws + WS_Y);
        float* RS = LSE; float* CS = LSE + M;
        { const int NR = M + DM;
          for (int r = 2 * gw; r < NR; r += 2 * NGW) {
              if (r < M) quant_row2(XN2 + (size_t)r * DM, XN2 + (size_t)(r + 1) * DM, XQ + (size_t)r * DM, XQ + (size_t)(r + 1) * DM, RS + ss_of_row(r), RS + ss_of_row(r + 1), 1.0f, 1.0f, lane);
              else { const int n = r - M; quant_row2(WOUT + (size_t)n * DM, WOUT + (size_t)(n + 1) * DM, WQ + (size_t)n * DM, WQ + (size_t)(n + 1) * DM, CS + n, CS + n + 1, 1.0f, 1.0f, lane); } } }
        xcd_barrier(bar);
        pg8::Gemm g{(const pg8::bf16_t*)XQ, (const pg8::bf16_t*)WQ, M, DM, DM / 2, DM / 2, DM / 2, 256, 256}; pg8::StaticOrder S; S.init(M, DM, G, bx);
        pg8::EpiResQ E{XN, DM, XN, DM, RS, CS, SS2};
        pg8::gemm_phase<pg8::EpiResQ, pg8::StaticOrder, true, true>(lds + RING_OFF, g, S, E, wave);
    }
    SEAM(8);
    if (IN(9)) {
        pg8::Gemm g{XN, WGU, M, 2 * FF, DM, DM, DM, 256, 256}; pg8::StaticOrder S; S.init(M, 2 * FF, G, bx);
        pg8::EpiSwiGLU E{HID, M, SS2, 1.0f / DM, RMS_EPS};
        pg8::gemm_phase<pg8::EpiSwiGLU, pg8::StaticOrder, true>(lds + RING_OFF, g, S, E, wave);
        if (TAIL9_ITEMS > 0) TAIL_WORK((M / 256) * (2 * FF / 256), TAIL9_ITEMS, tr_blocked(args.in[I_W2D], DM, WDN, it, scr, lane));
    }
    SEAM(9);
    if (IN(10)) {
        pg8::Gemm g{HID, WDN, M, DM, FF, 128, 128, (size_t)M * 256, (size_t)DM * 256}; pg8::BandOrder S; S.init(M, DM, G, bx);
        pg8::EpiRes<true, false, false> E{XN, DM, Hs, DM, 0.5f, nullptr};
        pg8::gemm_phase<pg8::EpiRes<true, false, false>, pg8::BandOrder, true>(lds + RING_OFF, g, S, E, wave);
    }
    SEAM(10);
    if (IN(11)) {
        { int m = gw;
          for (; m + NGW < M; m += 2 * NGW) rms_row2<false>(Hs + (size_t)m * DM, Hs + (size_t)(m + NGW) * DM, args.in[I_GFIN], Hs + (size_t)m * DM, Hs + (size_t)(m + NGW) * DM, lane);
          if (m < M) rms_row_to_f32(Hs + (size_t)m * DM, args.in[I_GFIN], Hs + (size_t)m * DM, lane); }
    }
#undef IN
#undef SEAM
#undef lane
#undef tid
}

#ifndef MK_PER_PHASE
#define MK_PER_PHASE 0
#endif
extern "C" void kernel_launch(void* const* d_in, const int* in_sizes, int n_in, void* d_out, int out_size, void* d_ws, size_t ws_size, hipStream_t stream) {
    static int grid = 0;
    if (grid == 0) {
        if (n_in != 17 || in_sizes[0] != M * DM || out_size != M * DM || ws_size < WS_END) {
            fprintf(stderr, "kernel_launch: shape mismatch: n_in %d in0 %d out %d ws %zu (need >= %zu); nothing launched\n", n_in, n_in > 0 ? in_sizes[0] : -1, out_size, ws_size, (size_t)WS_END); grid = -1; return; }
        int dev = 0, cus = 0, per_cu = 0;
        if (hipGetDevice(&dev) != hipSuccess || hipDeviceGetAttribute(&cus, hipDeviceAttributeMultiprocessorCount, dev) != hipSuccess) { fprintf(stderr, "kernel_launch: device query failed\n"); grid = -1; return; }
        if (hipFuncSetAttribute((const void*)hyb_fwd, hipFuncAttributeMaxDynamicSharedMemorySize, LDS_BYTES) != hipSuccess) { fprintf(stderr, "kernel_launch: hipFuncSetAttribute failed\n"); grid = -1; return; }
        if (hipOccupancyMaxActiveBlocksPerMultiprocessor(&per_cu, (const void*)hyb_fwd, NWAVES * 64, LDS_BYTES) != hipSuccess || per_cu < 1)
            fprintf(stderr, "kernel_launch: note: occupancy query reports %d workgroups per CU\n", per_cu);
        (void)hipGetLastError();
        grid = cus;
    }
    if (grid < 0) return;
    if (hipMemsetAsync((char*)d_ws + WS_CTL, 0, CTL_ZERO_BYTES, stream) != hipSuccess) { fprintf(stderr, "kernel_launch: memset failed\n"); return; }
    Args a{};
    for (int i = 0; i < 17; ++i) a.in[i] = (const float*)d_in[i];
    a.out = (float*)d_out; a.ws = (unsigned char*)d_ws;
#if MK_PER_PHASE
    for (int p = 0; p < N_PHASES; ++p) { a.ph_lo = p; a.ph_hi = p + 1; hipLaunchKernelGGL(hyb_fwd, dim3(grid), dim3(NWAVES * 64), LDS_BYTES, stream, a); }
#else
    a.ph_lo = 0; a.ph_hi = N_PHASES;
    hipLaunchKernelGGL(hyb_fwd, dim3(grid), dim3(NWAVES * 64), LDS_BYTES, stream, a);
#endif
    const hipError_t le = hipPeekAtLastError();
    if (le != hipSuccess) fprintf(stderr, "kernel_launch: launch failed: %s\n", hipGetErrorName(le));
}
```
